# Optimizing an MI355X kernel written in HIP

```python
import functools
import jax, jax.numpy as jnp
from jax import lax
import numpy as np

D_MODEL = 1024
BATCH = 16
SEQ = 2048
DEPTH = 1
DEC_BATCH = 128
DEC_SEQ = 1
PAST_LEN = 16384
PAGE_SIZE = 128

HEAD_DIM = 64
A_Q_HEADS = 8
A_KV_HEADS = 2
A_GROUP = A_Q_HEADS // A_KV_HEADS
A_WINDOW = 128
B_PATTERNS = ((128, 1), (512, 4), (2048, 16))
B_N_GROUPS = 3
B_HEADS_PER_GROUP = 4
B_HEADS = B_N_GROUPS * B_HEADS_PER_GROUP
WIN_UNITS = 128
BLOCK = WIN_UNITS
D_FF = 2816
EPS = 1e-6
ATTN_SCALE = HEAD_DIM ** -0.5
N_ALIBI_HEADS = A_Q_HEADS + B_HEADS
A_W = A_Q_HEADS * HEAD_DIM
A_KVW = A_KV_HEADS * HEAD_DIM
B_W = B_HEADS * HEAD_DIM
B_OUT_W = B_HEADS_PER_GROUP * HEAD_DIM
IN_W = A_W + 2 * A_KVW + 3 * B_W + 2 * D_MODEL

kernel_name = "gated_parallel_swa_sink_dilated_macaron_step"


def rmsnorm(x, g):
    xf = x.astype(jnp.float32)
    y = xf * lax.rsqrt(jnp.mean(xf * xf, axis=-1, keepdims=True) + EPS)
    return (y * g.astype(jnp.float32)).astype(x.dtype)


def swiglu(x, w_gate, w_up, w_down):
    return (jax.nn.silu(x @ w_gate) * (x @ w_up)) @ w_down


def alibi_slopes():
    i = jnp.arange(1, N_ALIBI_HEADS + 1, dtype=jnp.float32)
    return jnp.exp2(-8.0 * i / N_ALIBI_HEADS)


def a_slopes(slopes):
    return slopes[:A_Q_HEADS].reshape(A_KV_HEADS, A_GROUP)


def b_slopes(slopes, g):
    lo = A_Q_HEADS + g * B_HEADS_PER_GROUP
    return slopes[lo:lo + B_HEADS_PER_GROUP].reshape(B_HEADS_PER_GROUP, 1)


def pad_seq(t, length):
    return jnp.pad(t, [(0, 0), (0, length - t.shape[1])] + [(0, 0)] * (t.ndim - 2))


def fold(t, d):
    n, sp = t.shape[:2]
    t = jnp.moveaxis(t.reshape(n, sp // d, d, *t.shape[2:]), 2, 1)
    return t.reshape(n * d, sp // d, *t.shape[3:])


def unfold(t, d, n):
    u = t.shape[1]
    t = jnp.moveaxis(t.reshape(n, d, u, *t.shape[2:]), 1, 2)
    return t.reshape(n, u * d, *t.shape[3:])


def attend(s, mask, sink):
    s = jnp.where(mask, s, -jnp.inf)
    m = jnp.max(s, axis=-1)
    if sink is not None:
        sink = sink.astype(jnp.float32)
        m = jnp.maximum(m, sink)
    p = jnp.exp(s - m[..., None])
    denom = jnp.sum(p, axis=-1)
    if sink is not None:
        denom = denom + jnp.exp(sink - m)
    return p / denom[..., None], m + jnp.log(denom)


def banded_window_attention(q, k, v, slopes, dil, sink):
    n, length, kvh, grp, hd = q.shape
    nb = length // BLOCK
    qb = q.reshape(n, nb, BLOCK, kvh, grp, hd)
    kb = k.reshape(n, nb, BLOCK, kvh, hd)
    vb = v.reshape(n, nb, BLOCK, kvh, hd)
    shift = lambda t: jnp.concatenate([jnp.zeros_like(t[:, :1]), t[:, :-1]], axis=1)
    kk = jnp.concatenate([shift(kb), kb], axis=2)
    vv = jnp.concatenate([shift(vb), vb], axis=2)
    s = jnp.einsum('nbqkgd,nbskd->nbkgqs', qb, kk, preferred_element_type=jnp.float32) * ATTN_SCALE
    qi = jnp.arange(BLOCK)[:, None] + BLOCK
    ki = jnp.arange(2 * BLOCK)[None, :]
    dist = qi - ki
    band = (dist >= 0) & (dist <= WIN_UNITS)
    key_ok = (jnp.arange(nb)[:, None] * BLOCK - BLOCK + ki) >= 0
    mask = (band[None] & key_ok[:, None, :])[None, :, None, None]
    s = s - slopes.astype(jnp.float32)[:, :, None, None] * (dil * dist).astype(jnp.float32)
    p, lse = attend(s, mask, None if sink is None else sink[:, :, None])
    o = jnp.einsum('nbkgqs,nbskd->nbqkgd', p.astype(v.dtype), vv)
    lse = jnp.transpose(lse, (0, 1, 4, 2, 3)).reshape(n, length, kvh, grp)
    return o.reshape(n, length, kvh, grp, hd), lse


def gathered_window_attention(q, k_all, v_all, q_off, dil, slopes, sink):
    t = q.shape[1]
    mstep = jnp.arange(WIN_UNITS + 1)
    idx = (q_off + jnp.arange(t))[:, None] - dil * mstep[None, :]
    valid = idx >= 0
    idx = jnp.maximum(idx, 0)
    kg = jnp.take(k_all, idx, axis=1)
    vg = jnp.take(v_all, idx, axis=1)
    s = jnp.einsum('ntkgd,ntmkd->ntkgm', q, kg, preferred_element_type=jnp.float32) * ATTN_SCALE
    s = s - slopes.astype(jnp.float32)[:, :, None] * (dil * mstep).astype(jnp.float32)
    p, lse = attend(s, valid[None, :, None, None, :], sink)
    o = jnp.einsum('ntkgm,ntmkd->ntkgd', p.astype(v_all.dtype), vg)
    return o, lse


def project_heads(h, w_in, q_norm_a, k_norm_a, q_norm_b, k_norm_b):
    n, t, _ = h.shape
    z = h @ w_in
    cuts = [A_W, A_W + A_KVW, A_W + 2 * A_KVW, A_W + 2 * A_KVW + B_W,
            A_W + 2 * A_KVW + 2 * B_W, A_W + 2 * A_KVW + 3 * B_W,
            A_W + 2 * A_KVW + 3 * B_W + D_MODEL]
    qa, ka, va, qb, kb, vb, ga, gb = jnp.split(z, cuts, axis=-1)
    qa = rmsnorm(qa.reshape(n, t, A_KV_HEADS, A_GROUP, HEAD_DIM), q_norm_a)
    ka = rmsnorm(ka.reshape(n, t, A_KV_HEADS, HEAD_DIM), k_norm_a)
    va = va.reshape(n, t, A_KV_HEADS, HEAD_DIM)
    qb = rmsnorm(qb.reshape(n, t, B_N_GROUPS, B_HEADS_PER_GROUP, HEAD_DIM), q_norm_b)
    kb = rmsnorm(kb.reshape(n, t, B_N_GROUPS, B_HEADS_PER_GROUP, HEAD_DIM), k_norm_b)
    vb = vb.reshape(n, t, B_N_GROUPS, B_HEADS_PER_GROUP, HEAD_DIM)
    return qa, ka, va, qb, kb, vb, ga, gb


def merge(o_a, o_b, lse_b, ga, gb, w_up_a, w_up_b, w_o):
    n, t = o_a.shape[:2]
    wts = jax.nn.softmax(lse_b, axis=2)
    ob = jnp.sum(wts[..., None] * o_b.astype(jnp.float32), axis=2).astype(o_b.dtype)
    ua = o_a.reshape(n, t, A_W) @ w_up_a
    ub = ob.reshape(n, t, B_OUT_W) @ w_up_b
    return (jax.nn.sigmoid(ga) * ua + jax.nn.sigmoid(gb) * ub) @ w_o


def mixer_prompt(h, proj, sinks, outp, slopes):
    qa, ka, va, qb, kb, vb, ga, gb = project_heads(h, *proj)
    n, s_len = h.shape[:2]
    sa = -(-s_len // BLOCK) * BLOCK
    o_a, _ = banded_window_attention(pad_seq(qa, sa), pad_seq(ka, sa), pad_seq(va, sa),
                                     a_slopes(slopes), 1, sinks)
    o_a = o_a[:, :s_len]
    states = [jnp.stack([ka, va], axis=2)[:, s_len - min(A_WINDOW, s_len):]]
    o_b, lse_b = [], []
    for g, (win, dil) in enumerate(B_PATTERNS):
        sp = -(-s_len // (dil * BLOCK)) * dil * BLOCK
        q = fold(pad_seq(qb[:, :, g, :, None], sp), dil)
        k = fold(pad_seq(kb[:, :, g], sp), dil)
        v = fold(pad_seq(vb[:, :, g], sp), dil)
        o, lse = banded_window_attention(q, k, v, b_slopes(slopes, g), dil, None)
        o_b.append(unfold(o, dil, n)[:, :s_len, :, 0])
        lse_b.append(unfold(lse, dil, n)[:, :s_len, :, 0])
        states.append(jnp.stack([kb[:, :, g], vb[:, :, g]], axis=2)[:, s_len - min(win, s_len):])
    y = merge(o_a, jnp.stack(o_b, axis=2), jnp.stack(lse_b, axis=2), ga, gb, *outp)
    return y, states


def mixer_step(h, bufs, proj, sinks, outp, slopes):
    qa, ka, va, qb, kb, vb, ga, gb = project_heads(h, *proj)
    t = h.shape[1]

    def extend(buf, k, v, win):
        rows = jnp.concatenate([buf, jnp.stack([k, v], axis=2)], axis=1)
        return rows[:, :, 0], rows[:, :, 1], rows[:, -min(win, buf.shape[1] + t):]

    k_all, v_all, new_a = extend(bufs[0], ka, va, A_WINDOW)
    o_a, _ = gathered_window_attention(qa, k_all, v_all, bufs[0].shape[1], 1, a_slopes(slopes), sinks)
    states = [new_a]
    o_b, lse_b = [], []
    for g, (win, dil) in enumerate(B_PATTERNS):
        buf = bufs[1 + g]
        k_all, v_all, new_b = extend(buf, kb[:, :, g], vb[:, :, g], win)
        o, lse = gathered_window_attention(qb[:, :, g, :, None], k_all, v_all, buf.shape[1], dil,
                                           b_slopes(slopes, g), None)
        o_b.append(o[:, :, :, 0])
        lse_b.append(lse[..., 0])
        states.append(new_b)
    y = merge(o_a, jnp.stack(o_b, axis=2), jnp.stack(lse_b, axis=2), ga, gb, *outp)
    return y, states


def macaron_layer(x, mixer, norm_ffn1, w1_gate, w1_up, w1_down, norm_mix,
                  norm_ffn2, w2_gate, w2_up, w2_down):
    x = x + 0.5 * swiglu(rmsnorm(x, norm_ffn1), w1_gate, w1_up, w1_down)
    mixed, states = mixer(rmsnorm(x, norm_mix))
    x = x + mixed
    x = x + 0.5 * swiglu(rmsnorm(x, norm_ffn2), w2_gate, w2_up, w2_down)
    return x, states


def setup_inputs(seed: int = 0) -> dict:
    key = jax.random.key(seed)
    ks = iter(jax.random.split(key, 32))
    f32 = jnp.float32

    def nrm(shape, scale=1.0):
        return scale * jax.random.normal(next(ks), shape, f32)

    def gain(shape):
        return 1.0 + 0.02 * jax.random.normal(next(ks), shape, f32)

    def kv_buf(window, heads):
        return nrm((DEPTH, DEC_BATCH, min(window, PAST_LEN), 2, heads, HEAD_DIM))

    return {
        "x_prompt": nrm((BATCH, SEQ, D_MODEL)),
        "x_sample": nrm((DEC_BATCH, DEC_SEQ, D_MODEL)),
        "cache_a_kv": kv_buf(A_WINDOW, A_KV_HEADS),
        "cache_b1_kv": kv_buf(B_PATTERNS[0][0], B_HEADS_PER_GROUP),
        "cache_b2_kv": kv_buf(B_PATTERNS[1][0], B_HEADS_PER_GROUP),
        "cache_b3_kv": kv_buf(B_PATTERNS[2][0], B_HEADS_PER_GROUP),
        "norm_ffn1": gain((DEPTH, D_MODEL)),
        "w1_gate": nrm((DEPTH, D_MODEL, D_FF), D_MODEL ** -0.5),
        "w1_up": nrm((DEPTH, D_MODEL, D_FF), D_MODEL ** -0.5),
        "w1_down": nrm((DEPTH, D_FF, D_MODEL), D_FF ** -0.5),
        "norm_mix": gain((DEPTH, D_MODEL)),
        "w_in": nrm((DEPTH, D_MODEL, IN_W), D_MODEL ** -0.5),
        "q_norm_a": gain((DEPTH, HEAD_DIM)),
        "k_norm_a": gain((DEPTH, HEAD_DIM)),
        "q_norm_b": gain((DEPTH, HEAD_DIM)),
        "k_norm_b": gain((DEPTH, HEAD_DIM)),
        "sinks_a": nrm((DEPTH, A_KV_HEADS, A_GROUP), 0.5),
        "w_up_a": nrm((DEPTH, A_W, D_MODEL), A_W ** -0.5),
        "w_up_b": nrm((DEPTH, B_OUT_W, D_MODEL), B_OUT_W ** -0.5),
        "w_o": nrm((DEPTH, D_MODEL, D_MODEL), D_MODEL ** -0.5),
        "norm_ffn2": gain((DEPTH, D_MODEL)),
        "w2_gate": nrm((DEPTH, D_MODEL, D_FF), D_MODEL ** -0.5),
        "w2_up": nrm((DEPTH, D_MODEL, D_FF), D_MODEL ** -0.5),
        "w2_down": nrm((DEPTH, D_FF, D_MODEL), D_FF ** -0.5),
    }


def reference(x_prompt, x_sample, cache_a_kv, cache_b1_kv, cache_b2_kv, cache_b3_kv,
              norm_ffn1, w1_gate, w1_up, w1_down, norm_mix, w_in,
              q_norm_a, k_norm_a, q_norm_b, k_norm_b, sinks_a,
              w_up_a, w_up_b, w_o, norm_ffn2, w2_gate, w2_up, w2_down):
    slopes = alibi_slopes()
    yp, ys = x_prompt, x_sample
    st_p = ([], [], [], [])
    st_s = ([], [], [], [])
    for l in range(DEPTH):
        proj = (w_in[l], q_norm_a[l], k_norm_a[l], q_norm_b[l], k_norm_b[l])
        outp = (w_up_a[l], w_up_b[l], w_o[l])
        ffn = (norm_ffn1[l], w1_gate[l], w1_up[l], w1_down[l], norm_mix[l],
               norm_ffn2[l], w2_gate[l], w2_up[l], w2_down[l])
        bufs = (cache_a_kv[l], cache_b1_kv[l], cache_b2_kv[l], cache_b3_kv[l])
        yp, sp = macaron_layer(yp, functools.partial(mixer_prompt, proj=proj, sinks=sinks_a[l],
                                                     outp=outp, slopes=slopes), *ffn)
        ys, ss = macaron_layer(ys, functools.partial(mixer_step, bufs=bufs, proj=proj, sinks=sinks_a[l],
                                                     outp=outp, slopes=slopes), *ffn)
        for i in range(4):
            st_p[i].append(sp[i])
            st_s[i].append(ss[i])
    a_p, b1_p, b2_p, b3_p = [jnp.stack(s) for s in st_p]
    a_s, b1_s, b2_s, b3_s = [jnp.stack(s) for s in st_s]
    return (yp, ys, a_p, b1_p, b2_p, b3_p, a_s, b1_s, b2_s, b3_s)
```

```cpp
#include <hip/hip_runtime.h>
#include <hip/hip_cooperative_groups.h>
#include <cstdio>
#include <cstdint>
namespace cg = cooperative_groups;
namespace pg8 {
#define PG8_LAS __attribute__((address_space(3)))
typedef unsigned short bf16_t;
typedef short bf16x8 __attribute__((ext_vector_type(8)));
typedef float f32x4 __attribute__((ext_vector_type(4)));
typedef unsigned u32x4 __attribute__((ext_vector_type(4)));
constexpr int BM = 256, BK = 64, HALF = 128, HTB = HALF * BK * 2  , STAGE_BYTES = 8 * HTB, NXCD = 8, WGM = 8;

__host__ __device__ __forceinline__ int lds_byte(int r, int c) { const int st = (r >> 4) * 2 + (c >> 5), rr = r & 15, cc = c & 31, ob = rr * 64 + cc * 2; return st * 1024 + (ob ^ (((ob >> 9) & 1) << 5)); }
__host__ __device__ __forceinline__ void stage_rc(int b, int& R, int& C) { const int st = b / 1024, sb = b % 1024, swz = sb ^ (((sb >> 9) & 1) << 5); R = (st >> 1) * 16 + swz / 64; C = (st & 1) * 32 + (swz % 64) / 2; }
__host__ __device__ __forceinline__ int perm32(int rho) { const int n = rho >> 4, i = rho & 15; return 8 * (i >> 2) + 4 * n + (i & 3); }

struct Unit { int pm, pn; };
struct Gemm { const bf16_t* A; const bf16_t* Bt; int M, N, K; };

struct StaticOrder {
    int nM, nN, nwg, G, c;
    __host__ __device__ void init(int M, int N, int G_, int c_) { nM = M / BM; nN = N / BM; nwg = nM * nN; G = G_; c = c_; }
    __host__ __device__ bool next(int i, Unit& u) const {
        const long L = (long)i * G + c; if (L >= nwg) return false;
        int wgid = (int)L; { const int q = nwg / NXCD, r = nwg % NXCD, xcd = wgid % NXCD, off = wgid / NXCD; wgid = (xcd < r ? xcd * (q + 1) : r * (q + 1) + (xcd - r) * q) + off; }
        const int nig = WGM * nN, gid = wgid / nig, fm = gid * WGM, gsz = (nM - fm) < WGM ? (nM - fm) : WGM;
        u.pm = fm + ((wgid % nig) % gsz); u.pn = (wgid % nig) / gsz; return true;
    }
    __device__ __forceinline__ void a_ready(const Unit&) const {}
    __device__ __forceinline__ void done(const Unit&) const {}
};

__device__ __forceinline__ unsigned cvt_pk_bf16(float lo, float hi) { unsigned r; asm volatile("v_cvt_pk_bf16_f32 %0, %1, %2" : "=v"(r) : "v"(lo), "v"(hi)); return r; }
typedef float f32x2 __attribute__((ext_vector_type(2)));
template <class Epi, class Sched, bool ALIGN_EPI = false, bool SP2 = false>
__device__ __forceinline__ void gemm_phase(PG8_LAS unsigned char* lds, const Gemm g, const Sched& S, const Epi& E) {
    int tid_ = threadIdx.x; asm volatile("" : "+v"(tid_));
    const int tid = tid_, wid = __builtin_amdgcn_readfirstlane(tid >> 6), lane = tid & 63, wr = wid >> 2, wc = wid & 3, fr = lane & 15, fq = lane >> 4;
    const int K = g.K, nt = K / BK;
    unsigned voffA[2], voffB[2];
#pragma unroll
    for (int i = 0; i < 2; ++i) { int R, C; stage_rc(tid * 16 + i * 8192, R, C); const int Rb = Epi::PERM ? ((R & ~31) + perm32(R & 31)) : R;
        voffA[i] = (unsigned)(R * K + C) * 2u; voffB[i] = (unsigned)(Rb * K + C) * 2u; }
    const size_t kstep = (size_t)(BK * 2);
    const size_t hstep = (size_t)HALF * K * 2;
    const size_t tstep = 2 * hstep;
    const unsigned ldsw = (unsigned)wid * 1024u;
    const int aoff = lds_byte(wr * 64 + fr, fq * 8), boff = lds_byte(wc * 32 + fr, fq * 8);
#define PG8_SA(b, h) (((b) * 2 + (h)) * HTB)
#define PG8_SB(b, h) ((4 + (b) * 2 + (h)) * HTB)
#define PG8_STAGE(bufoff, gbase, voff) do { _Pragma("unroll") for (int _i = 0; _i < 2; ++_i) \
        __builtin_amdgcn_global_load_lds((const unsigned*)((const char*)(gbase) + (voff)[_i]), (PG8_LAS unsigned*)(lds + (bufoff) + ldsw + _i * 8192), 16, 0, 0); } while (0)
#define PG8_LDA(dst, b, h) do { _Pragma("unroll") for (int m = 0; m < 4; ++m) _Pragma("unroll") for (int k = 0; k < 2; ++k) dst[m][k] = *(const PG8_LAS bf16x8*)(lds + PG8_SA(b, h) + aoff + m * 2048 + k * 1024); } while (0)
#define PG8_LDB(dst, b, h) do { _Pragma("unroll") for (int n = 0; n < 2; ++n) _Pragma("unroll") for (int k = 0; k < 2; ++k) dst[n][k] = *(const PG8_LAS bf16x8*)(lds + PG8_SB(b, h) + boff + n * 2048 + k * 1024); } while (0)
#define PG8_MMA(ai, bj, At, Bt) do { __builtin_amdgcn_s_setprio(1); _Pragma("unroll") for (int m = 0; m < 4; ++m) _Pragma("unroll") for (int n = 0; n < 2; ++n) _Pragma("unroll") for (int k = 0; k < 2; ++k) \
        acc[ai][bj][m][n] = __builtin_amdgcn_mfma_f32_16x16x32_bf16(Bt[n][k], At[m][k], acc[ai][bj][m][n], 0, 0, 0); __builtin_amdgcn_s_setprio(0); } while (0)
#define PG8_WAIT_V(n) asm volatile("s_waitcnt vmcnt(" #n ")" ::: "memory")
#define PG8_WAIT_L(n) asm volatile("s_waitcnt lgkmcnt(" #n ")" ::: "memory")
#define PG8_BAR __builtin_amdgcn_s_barrier()
#define PG8_SCHED __builtin_amdgcn_sched_barrier(0)
    Unit cur, nxt; int ui = 0;
    if (!S.next(0, cur)) return;
    f32x4 acc[2][2][4][2];
#pragma unroll
    for (int a = 0; a < 2; ++a)
#pragma unroll
        for (int b = 0; b < 2; ++b)
#pragma unroll
            for (int m = 0; m < 4; ++m)
#pragma unroll
                for (int n = 0; n < 2; ++n) acc[a][b][m][n] = (f32x4){0.f, 0.f, 0.f, 0.f};
    bf16x8 At[4][2], B0[2][2], B1[2][2];
    const char* cA = (const char*)g.A + (size_t)cur.pm * tstep; const char* cB = (const char*)g.Bt + (size_t)cur.pn * tstep;
    S.a_ready(cur);
    if constexpr (SP2) {
        PG8_STAGE(PG8_SB(0, 0), cB, voffB); PG8_STAGE(PG8_SB(0, 1), cB + hstep, voffB); PG8_STAGE(PG8_SA(0, 0), cA, voffA); PG8_STAGE(PG8_SA(0, 1), cA + hstep, voffA);
        if (wr == 1) PG8_BAR;
        PG8_WAIT_V(2); PG8_BAR;
        PG8_STAGE(PG8_SB(1, 0), cB + kstep, voffB); PG8_STAGE(PG8_SA(1, 0), cA + kstep, voffA); PG8_STAGE(PG8_SB(1, 1), cB + hstep + kstep, voffB);
        PG8_WAIT_V(6); PG8_BAR;
    } else {
        PG8_STAGE(PG8_SB(0, 0), cB, voffB); PG8_STAGE(PG8_SA(0, 0), cA, voffA); PG8_STAGE(PG8_SB(0, 1), cB + hstep, voffB); PG8_STAGE(PG8_SA(0, 1), cA + hstep, voffA);
        if (wr == 1) PG8_BAR;
        PG8_WAIT_V(4); PG8_BAR;
        PG8_STAGE(PG8_SB(1, 0), cB + kstep, voffB); PG8_STAGE(PG8_SA(1, 0), cA + kstep, voffA); PG8_STAGE(PG8_SB(1, 1), cB + hstep + kstep, voffB);
        PG8_WAIT_V(6); PG8_BAR;
    }
    for (;;) {
        const bool has_next = S.next(ui + 1, nxt);
        const char* nA = has_next ? (const char*)g.A + (size_t)nxt.pm * tstep : cA; const char* nB = has_next ? (const char*)g.Bt + (size_t)nxt.pn * tstep : cB;
        for (int t = 0; t < nt; t += 2) {
            const bool last = (t == nt - 2);
            const char* a1 = cA + (size_t)(t + 1) * kstep;
            const char* a2 = last ? nA : cA + (size_t)(t + 2) * kstep; const char* b2 = last ? nB : cB + (size_t)(t + 2) * kstep;
            const char* a3 = a2 + kstep; const char* b3 = b2 + kstep;
            if (last && has_next) S.a_ready(nxt);
            if constexpr (SP2) {
            PG8_LDB(B0, 0, 0); PG8_LDB(B1, 0, 1); PG8_SCHED; PG8_LDA(At, 0, 0); PG8_STAGE(PG8_SA(1, 1), a1 + hstep, voffA);
            PG8_WAIT_V(8); PG8_WAIT_L(0); PG8_BAR; PG8_MMA(0, 0, At, B0); PG8_MMA(0, 1, At, B1); PG8_BAR; PG8_SCHED;
            PG8_LDA(At, 0, 1); PG8_STAGE(PG8_SB(0, 0), b2, voffB); PG8_STAGE(PG8_SB(0, 1), b2 + hstep, voffB); PG8_STAGE(PG8_SA(0, 0), a2, voffA);
            PG8_WAIT_V(8); PG8_WAIT_L(0); PG8_BAR; PG8_MMA(1, 0, At, B0); PG8_MMA(1, 1, At, B1); PG8_BAR; PG8_SCHED;
            PG8_LDB(B0, 1, 0); PG8_LDB(B1, 1, 1); PG8_SCHED; PG8_LDA(At, 1, 0); PG8_STAGE(PG8_SA(0, 1), a2 + hstep, voffA);
            PG8_WAIT_V(8); PG8_WAIT_L(0); PG8_BAR; PG8_MMA(0, 0, At, B0); PG8_MMA(0, 1, At, B1); PG8_BAR; PG8_SCHED;
            PG8_LDA(At, 1, 1); PG8_STAGE(PG8_SB(1, 0), b3, voffB); PG8_STAGE(PG8_SB(1, 1), b3 + hstep, voffB); PG8_STAGE(PG8_SA(1, 0), a3, voffA);
            PG8_WAIT_V(8); PG8_WAIT_L(0); PG8_BAR; PG8_MMA(1, 0, At, B0); PG8_MMA(1, 1, At, B1); PG8_BAR; PG8_SCHED;
            } else {
            PG8_LDB(B0, 0, 0); PG8_SCHED; PG8_LDA(At, 0, 0); PG8_STAGE(PG8_SA(1, 1), a1 + hstep, voffA);
            PG8_WAIT_L(8); PG8_BAR; PG8_WAIT_L(0); PG8_MMA(0, 0, At, B0); PG8_BAR; PG8_SCHED;
            PG8_LDB(B1, 0, 1); PG8_STAGE(PG8_SB(0, 0), b2, voffB);
            PG8_BAR; PG8_WAIT_L(0); PG8_MMA(0, 1, At, B1); PG8_BAR;
            PG8_LDA(At, 0, 1); PG8_STAGE(PG8_SA(0, 0), a2, voffA);
            PG8_BAR; PG8_WAIT_L(0); PG8_MMA(1, 0, At, B0); PG8_BAR; PG8_SCHED;
            PG8_STAGE(PG8_SB(0, 1), b2 + hstep, voffB);
            PG8_WAIT_V(6); PG8_BAR; PG8_MMA(1, 1, At, B1); PG8_BAR;
            PG8_LDB(B0, 1, 0); PG8_SCHED; PG8_LDA(At, 1, 0); PG8_STAGE(PG8_SA(0, 1), a2 + hstep, voffA);
            PG8_WAIT_L(8); PG8_BAR; PG8_WAIT_L(0); PG8_MMA(0, 0, At, B0); PG8_BAR; PG8_SCHED;
            PG8_LDB(B1, 1, 1); PG8_STAGE(PG8_SB(1, 0), b3, voffB);
            PG8_BAR; PG8_WAIT_L(0); PG8_MMA(0, 1, At, B1); PG8_BAR;
            PG8_LDA(At, 1, 1); PG8_STAGE(PG8_SA(1, 0), a3, voffA);
            PG8_BAR; PG8_WAIT_L(0); PG8_MMA(1, 0, At, B0); PG8_BAR; PG8_SCHED;
            PG8_STAGE(PG8_SB(1, 1), b3 + hstep, voffB);
            PG8_WAIT_V(6); PG8_BAR; PG8_MMA(1, 1, At, B1); PG8_BAR;
            }
        }
        if constexpr (ALIGN_EPI) { if (wr == 0) PG8_BAR; }
        if constexpr (!Epi::AFTER_DRAIN) { E(acc, cur, wr, wc, fr, fq); S.done(cur); }
        if (!has_next) break;
#pragma unroll
        for (int a = 0; a < 2; ++a)
#pragma unroll
            for (int b = 0; b < 2; ++b)
#pragma unroll
                for (int m = 0; m < 4; ++m)
#pragma unroll
                    for (int n = 0; n < 2; ++n) acc[a][b][m][n] = (f32x4){0.f, 0.f, 0.f, 0.f};
        cur = nxt; cA = nA; cB = nB; ++ui;
        if constexpr (ALIGN_EPI) { if (wr == 1) PG8_BAR; }
    }
    PG8_WAIT_V(0);
    if constexpr (!ALIGN_EPI) { if (wr == 0) PG8_BAR; }
    PG8_BAR;
    if constexpr (Epi::AFTER_DRAIN) { E.fused(acc, cur, wr, wc, fr, fq, lds, wid, lane); S.done(cur); }
#undef PG8_SA
#undef PG8_SB
#undef PG8_STAGE
#undef PG8_LDA
#undef PG8_LDB
#undef PG8_MMA
#undef PG8_WAIT_V
#undef PG8_WAIT_L
#undef PG8_BAR
#undef PG8_SCHED
}
}

#ifndef PG8_SP2
#define PG8_SP2 true
#endif
#define LAS __attribute__((address_space(3)))
typedef unsigned short bf16;
typedef pg8::f32x4 f32x4;
typedef pg8::u32x4 u32x4;
typedef pg8::bf16x8 bf16x8;
typedef unsigned u32x2 __attribute__((ext_vector_type(2)));
typedef float f32x16 __attribute__((ext_vector_type(16)));
typedef short s16x4 __attribute__((ext_vector_type(4)));
using pg8::cvt_pk_bf16;

constexpr int DM = 1024, DFF = 2816, SEQ = 2048, MPR = 32768, NS = 128, MV = MPR + NS, MP = 33024, INW = 5120;
constexpr float EPS = 1e-6f;
constexpr float LOG2E = 1.4426950408889634f, LN2 = 0.6931471805599453f;
constexpr float QSCALE = 0.125f * LOG2E;
constexpr size_t MiB = 1u << 20;
constexpr size_t WS_SS1 = 0, WS_SS2 = 256 * 1024, WS_SS3 = 512 * 1024, WS_GT = 768 * 1024;
constexpr size_t WS_W1GU = 1 * MiB, WS_W1D = 13 * MiB, WS_WIN = 19 * MiB, WS_WUA = 29 * MiB, WS_WUB = 30 * MiB, WS_WO = 31 * MiB, WS_W2GU = 33 * MiB, WS_W2D = 45 * MiB;
constexpr size_t WS_XB = 52 * MiB, WS_H = 117 * MiB, WS_X1 = 295 * MiB, WS_X1B = 424 * MiB, WS_QP = 489 * MiB, WS_KP = 569 * MiB, WS_VP = 625 * MiB, WS_QS = 681 * MiB;
constexpr size_t WS_G = 682 * MiB, WS_OA = 811 * MiB, WS_OB3 = 844 * MiB, WS_LSE3 = 893 * MiB, WS_OBM = 895 * MiB, WS_MIXF = 912 * MiB, WS_MIXB = 1041 * MiB, WS_X2B = 1106 * MiB, WS_END = 1171 * MiB;
constexpr size_t O_YP = 0, O_YS = 33554432, O_AP = 33685504, O_B1P = 34209792, O_B2P = 35258368, O_B3P = 39452672, O_AS = 56229888, O_B1S = 60424192, O_B2S = 68812800, O_B3S = 102367232;

constexpr int ATT_KROW = 144, ATT_HALF = 2 * 256 * ATT_KROW, ATT_PL = 2 * ATT_HALF;
constexpr int LDS_BYTES = ATT_PL + 8 * 1024;

struct Params {
    const float* in[24];
    float* out;
    unsigned char* ws;
};

__device__ __forceinline__ float wave_sum(float v) {
#pragma unroll
    for (int o = 1; o < 64; o <<= 1) v += __shfl_xor(v, o);
    return v;
}
__device__ __forceinline__ float wave_max(float v) {
#pragma unroll
    for (int o = 1; o < 64; o <<= 1) v = fmaxf(v, __shfl_xor(v, o));
    return v;
}
__device__ __forceinline__ float bf2f(unsigned short b) { return __builtin_bit_cast(float, (unsigned)b << 16); }
__device__ __forceinline__ float sigmoidf_(float x) { return __builtin_amdgcn_rcpf(1.f + __builtin_amdgcn_exp2f(-x * LOG2E)); }

__device__ __forceinline__ void tr_item(const float* __restrict__ W, int ldw, int k0, int ns0, bf16* WT, int K, int nd0, const float* __restrict__ gain, LAS float* scr, int lane) {
#pragma unroll 8
    for (int i = 0; i < 32; ++i) { const int kk = 2 * i + (lane >> 5); float w = W[(size_t)(k0 + kk) * ldw + ns0 + (lane & 31)]; if (gain) w *= gain[k0 + kk]; scr[kk * 33 + (lane & 31)] = w; }
    asm volatile("s_waitcnt lgkmcnt(0)" ::: "memory");
    const int c = lane & 7;
#pragma unroll
    for (int j = 0; j < 4; ++j) { const int n = (lane >> 3) + 8 * j; const LAS float* s = scr + (8 * c) * 33 + n;
        u32x4 o; o.x = cvt_pk_bf16(s[0 * 33], s[1 * 33]); o.y = cvt_pk_bf16(s[2 * 33], s[3 * 33]); o.z = cvt_pk_bf16(s[4 * 33], s[5 * 33]); o.w = cvt_pk_bf16(s[6 * 33], s[7 * 33]);
        *(u32x4*)(WT + (size_t)(nd0 + n) * K + k0 + 8 * c) = o; }
    asm volatile("s_waitcnt lgkmcnt(0)" ::: "memory");
}
template <int L, int R> __device__ __forceinline__ void copy_cache(const float* __restrict__ src, float* __restrict__ dst, long gtid, long gthreads) {
    constexpr long PER = (long)(L - 1) * R / 4, TOT = 128L * PER, LR4 = (long)L * R / 4;
    const f32x4* s4 = (const f32x4*)src; f32x4* d4 = (f32x4*)dst;
    long i = gtid;
    for (; i + 3 * gthreads < TOT; i += 4 * gthreads) {
        f32x4 v[4];
#pragma unroll
        for (int u = 0; u < 4; ++u) { const long ii = i + u * gthreads; const long n = ii / PER, j = ii - n * PER; v[u] = __builtin_nontemporal_load(s4 + n * LR4 + R / 4 + j); }
#pragma unroll
        for (int u = 0; u < 4; ++u) { const long ii = i + u * gthreads; const long n = ii / PER, j = ii - n * PER; __builtin_nontemporal_store(v[u], d4 + n * LR4 + j); }
    }
    for (; i < TOT; i += gthreads) { const long n = i / PER, j = i - n * PER; __builtin_nontemporal_store(__builtin_nontemporal_load(s4 + n * LR4 + R / 4 + j), d4 + n * LR4 + j); }
}

__device__ __forceinline__ void phase_prologue(const Params& P, LAS unsigned char* lds) {
    const int tid = threadIdx.x, lane = tid & 63, wave = tid >> 6;
    const int gw = blockIdx.x * 8 + wave, NGW = gridDim.x * 8;
    unsigned char* ws = P.ws;
    LAS float* scr = (LAS float*)(lds + wave * 16384);
    constexpr int I_GU = 16 * 176, I_D = 44 * 32, I_IN = 16 * 160, I_UA = 8 * 32, I_UB = 4 * 32, I_O = 16 * 32;
    constexpr int NITEMS = 2 * I_GU + 2 * I_D + I_IN + I_UA + I_UB + I_O;
    for (int it = gw; it < NITEMS; it += NGW) {
        int r = it;
        if (r < 2 * I_GU) { const int L = r / I_GU; r -= L * I_GU; const int kb = r / 176, nb = r % 176, nd0 = 32 * nb, pn = nd0 >> 8, bj = (nd0 >> 7) & 1, c = nd0 & 127;
            const float* W = P.in[L ? (bj ? 22 : 21) : (bj ? 8 : 7)];
            tr_item(W, DFF, 64 * kb, 128 * pn + c, (bf16*)(ws + (L ? WS_W2GU : WS_W1GU)), DM, nd0, P.in[L ? 20 : 6], scr, lane); continue; }
        r -= 2 * I_GU;
        if (r < 2 * I_D) { const int L = r / I_D; r -= L * I_D; const int kb = r / 32, nb = r % 32;
            tr_item(P.in[L ? 23 : 9], DM, 64 * kb, 32 * nb, (bf16*)(ws + (L ? WS_W2D : WS_W1D)), DFF, 32 * nb, nullptr, scr, lane); continue; }
        r -= 2 * I_D;
        if (r < I_IN) { const int kb = r / 160, nb = r % 160, nd0 = 32 * nb; int ns0 = nd0;
            if (nd0 < 3072) { const int pn = nd0 >> 8, cl = nd0 & 255, bj = cl >> 7, wc = (cl >> 5) & 3; ns0 = 64 * (4 * pn + wc) + 32 * bj; }
            tr_item(P.in[11], INW, 64 * kb, ns0, (bf16*)(ws + WS_WIN), DM, nd0, P.in[10], scr, lane); continue; }
        r -= I_IN;
        if (r < I_UA) { const int kb = r / 32, nb = r % 32; tr_item(P.in[17], DM, 64 * kb, 32 * nb, (bf16*)(ws + WS_WUA), 512, 32 * nb, nullptr, scr, lane); continue; }
        r -= I_UA;
        if (r < I_UB) { const int kb = r / 32, nb = r % 32; tr_item(P.in[18], DM, 64 * kb, 32 * nb, (bf16*)(ws + WS_WUB), 256, 32 * nb, nullptr, scr, lane); continue; }
        r -= I_UB;
        { const int kb = r / 32, nb = r % 32; tr_item(P.in[19], DM, 64 * kb, 32 * nb, (bf16*)(ws + WS_WO), DM, 32 * nb, nullptr, scr, lane); }
    }
    float* ss1 = (float*)(ws + WS_SS1); float* ss2 = (float*)(ws + WS_SS2); float* ss3 = (float*)(ws + WS_SS3);
    bf16* XB = (bf16*)(ws + WS_XB);
    for (int m = gw; m < MP; m += NGW) {
        unsigned long long* o8 = (unsigned long long*)(XB + (size_t)m * DM) + lane;
        if (m < MV) {
            const float* xr = (m < MPR) ? P.in[0] + (size_t)m * DM : P.in[1] + (size_t)(m - MPR) * DM;
            const f32x4* x4 = (const f32x4*)xr + lane; f32x4 v[4]; float s = 0.f;
#pragma unroll
            for (int j = 0; j < 4; ++j) { v[j] = x4[64 * j]; s += (v[j].x * v[j].x + v[j].y * v[j].y) + (v[j].z * v[j].z + v[j].w * v[j].w); }
            s = wave_sum(s);
#pragma unroll
            for (int j = 0; j < 4; ++j) o8[64 * j] = (unsigned long long)cvt_pk_bf16(v[j].x, v[j].y) | ((unsigned long long)cvt_pk_bf16(v[j].z, v[j].w) << 32);
            if (lane == 0) ss1[m] = s;
        } else {
#pragma unroll
            for (int j = 0; j < 4; ++j) o8[64 * j] = 0ull;
            if (lane == 0) ss1[m] = 0.f;
        }
    }
    const long gtid = (long)blockIdx.x * 512 + tid, gthreads = (long)gridDim.x * 512;
    for (long i = gtid; i < MP; i += gthreads) { ss2[i] = 0.f; ss3[i] = 0.f; }
    if (blockIdx.x == 0 && tid < 320) { float* GT = (float*)(ws + WS_GT); const int r = tid >> 6, d = tid & 63;
        float v = 1.f; if (r == 0) v = P.in[12][d] * QSCALE; else if (r == 1) v = P.in[13][d]; else if (r == 2) v = P.in[14][d] * QSCALE; else if (r == 3) v = P.in[15][d];
        GT[tid] = v; }
    copy_cache<128, 256>(P.in[2], P.out + O_AS, gtid, gthreads);
    copy_cache<128, 512>(P.in[3], P.out + O_B1S, gtid, gthreads);
    copy_cache<512, 512>(P.in[4], P.out + O_B2S, gtid, gthreads);
    copy_cache<2048, 512>(P.in[5], P.out + O_B3S, gtid, gthreads);
}

struct EpiSwiGLU {
    static constexpr bool PERM = true, AFTER_DRAIN = false;
    bf16* H; const float* ss;
    __device__ __forceinline__ void operator()(const f32x4 (&acc)[2][2][4][2], const pg8::Unit& u, int wr, int wc, int fr, int fq) const {
        const int row0 = u.pm * 256 + wr * 64 + fr, col0 = u.pn * 128 + wc * 32 + 8 * fq;
#pragma unroll
        for (int ai = 0; ai < 2; ++ai)
#pragma unroll
            for (int m = 0; m < 4; ++m) { const int row = row0 + ai * 128 + m * 16; const float rs = __builtin_amdgcn_rsqf(ss[row] * (1.f / DM) + EPS);
                float h[8];
#pragma unroll
                for (int n = 0; n < 2; ++n)
#pragma unroll
                    for (int j = 0; j < 4; ++j) { const float g = acc[ai][0][m][n][j] * rs, up = acc[ai][1][m][n][j] * rs; h[4 * n + j] = g * sigmoidf_(g) * up; }
                u32x4 w; w.x = cvt_pk_bf16(h[0], h[1]); w.y = cvt_pk_bf16(h[2], h[3]); w.z = cvt_pk_bf16(h[4], h[5]); w.w = cvt_pk_bf16(h[6], h[7]);
                *(u32x4*)(H + (size_t)row * DFF + col0) = w; }
    }
};
struct EpiRes {
    static constexpr bool PERM = false, AFTER_DRAIN = false;
    const float* res_p; const float* res_s; float* out; bf16* outb; float* ss; float scale;
    __device__ __forceinline__ void operator()(const f32x4 (&acc)[2][2][4][2], const pg8::Unit& u, int wr, int wc, int fr, int fq) const {
        const int row0 = u.pm * 256 + wr * 64 + fr, col0 = u.pn * 256 + wc * 32 + 4 * fq;
#pragma unroll
        for (int ai = 0; ai < 2; ++ai)
#pragma unroll
            for (int m = 0; m < 4; ++m) { const int row = row0 + ai * 128 + m * 16;
                if (row < MV) {
                    const float* rp = (row < MPR) ? res_p + (size_t)row * DM : res_s + (size_t)(row - MPR) * DM;
                    float s = 0.f;
#pragma unroll
                    for (int bj = 0; bj < 2; ++bj)
#pragma unroll
                        for (int n = 0; n < 2; ++n) { const int col = col0 + bj * 128 + n * 16; const f32x4 r = *(const f32x4*)(rp + col); const f32x4 v = r + acc[ai][bj][m][n] * scale;
                            *(f32x4*)(out + (size_t)row * DM + col) = v;
                            if (outb) { u32x2 w; w.x = cvt_pk_bf16(v[0], v[1]); w.y = cvt_pk_bf16(v[2], v[3]); *(u32x2*)(outb + (size_t)row * DM + col) = w; }
                            s += (v[0] * v[0] + v[1] * v[1]) + (v[2] * v[2] + v[3] * v[3]); }
                    if (ss) { s += __shfl_xor(s, 16); s += __shfl_xor(s, 32); if (fq == 0) atomicAdd(ss + row, s); }
                }
            }
    }
};
struct EpiQKV {
    static constexpr bool PERM = false, AFTER_DRAIN = false;
    const float* ss; unsigned char* wsb; bf16* G; float* dout; const float* GT;
    __device__ __forceinline__ void operator()(const f32x4 (&acc)[2][2][4][2], const pg8::Unit& u, int wr, int wc, int fr, int fq) const {
        const int row0 = u.pm * 256 + wr * 64 + fr;
        if (u.pn >= 12) {
            const int col0 = (u.pn - 12) * 256 + wc * 32 + 4 * fq;
#pragma unroll
            for (int ai = 0; ai < 2; ++ai)
#pragma unroll
                for (int m = 0; m < 4; ++m) { const int row = row0 + ai * 128 + m * 16; const float rs = __builtin_amdgcn_rsqf(ss[row] * (1.f / DM) + EPS);
#pragma unroll
                    for (int bj = 0; bj < 2; ++bj)
#pragma unroll
                        for (int n = 0; n < 2; ++n) { const f32x4 a = acc[ai][bj][m][n] * rs; u32x2 w; w.x = cvt_pk_bf16(sigmoidf_(a[0]), sigmoidf_(a[1])); w.y = cvt_pk_bf16(sigmoidf_(a[2]), sigmoidf_(a[3]));
                            *(u32x2*)(G + (size_t)row * 2048 + col0 + bj * 128 + n * 16) = w; } }
            return;
        }
        const int hd = 4 * u.pn + wc;
        const bool isA = hd < 12; const int hb = isA ? 0 : hd - 12, t = hb / 12, jj = hb - 12 * t, g = isA ? 0 : (jj >> 2);
        const int kind = isA ? ((hd >= 8) + (hd >= 10)) : t;
        const int hs = isA ? (hd & 1) : (jj & 3), H = isA ? 2 : 4;
        const int idx = isA ? (kind == 0 ? hd : hs) : ((kind == 0 ? 8 : 2) + jj);
        const int sh = 2 * g, dil = 1 << sh, win = 128 << sh;
        const size_t so_p = isA ? O_AP : (O_B1P + (g > 0 ? O_B2P - O_B1P : 0) + (g > 1 ? O_B3P - O_B2P : 0));
        const size_t so_s = isA ? O_AS : (O_B1S + (g > 0 ? O_B2S - O_B1S : 0) + (g > 1 ? O_B3S - O_B2S : 0));
        const int gi = (kind == 2) ? 4 : ((isA ? 0 : 2) + kind);
        const size_t boff = WS_QP + (kind > 0 ? WS_KP - WS_QP : 0) + (kind > 1 ? WS_VP - WS_KP : 0); const int nh = kind == 0 ? 20 : 14;
        f32x4 gv[2][2];
#pragma unroll
        for (int bj = 0; bj < 2; ++bj)
#pragma unroll
            for (int n = 0; n < 2; ++n) gv[bj][n] = *(const f32x4*)(GT + gi * 64 + 32 * bj + 16 * n + 4 * fq);
#pragma unroll
        for (int ai = 0; ai < 2; ++ai)
#pragma unroll
            for (int m = 0; m < 4; ++m) { const int row = row0 + ai * 128 + m * 16; const float rs = __builtin_amdgcn_rsqf(ss[row] * (1.f / DM) + EPS);
                f32x4 v[2][2]; float s = 0.f;
#pragma unroll
                for (int bj = 0; bj < 2; ++bj)
#pragma unroll
                    for (int n = 0; n < 2; ++n) { v[bj][n] = acc[ai][bj][m][n] * rs; s += (v[bj][n][0] * v[bj][n][0] + v[bj][n][1] * v[bj][n][1]) + (v[bj][n][2] * v[bj][n][2] + v[bj][n][3] * v[bj][n][3]); }
                s += __shfl_xor(s, 16); s += __shfl_xor(s, 32);
                const float inv = (kind < 2) ? __builtin_amdgcn_rsqf(s * (1.f / 64.f) + EPS) : 1.f;
#pragma unroll
                for (int bj = 0; bj < 2; ++bj)
#pragma unroll
                    for (int n = 0; n < 2; ++n) v[bj][n] = v[bj][n] * gv[bj][n] * inv;
                if (row < MPR) {
                    const int b = row >> 11, sq = row & 2047, p = ((sq & (dil - 1)) << (11 - sh)) + (sq >> sh);
                    bf16* dst = (bf16*)(wsb + boff) + ((size_t)(b * nh + idx) * 2048 + p) * 64;
#pragma unroll
                    for (int bj = 0; bj < 2; ++bj)
#pragma unroll
                        for (int n = 0; n < 2; ++n) { u32x2 w; w.x = cvt_pk_bf16(v[bj][n][0], v[bj][n][1]); w.y = cvt_pk_bf16(v[bj][n][2], v[bj][n][3]); *(u32x2*)(dst + 32 * bj + 16 * n + 4 * fq) = w; }
                    if (kind > 0 && sq >= 2048 - win) {
                        float* sd = dout + so_p + ((((size_t)b * win + (sq - (2048 - win))) * 2 + (kind - 1)) * H + hs) * 64;
#pragma unroll
                        for (int bj = 0; bj < 2; ++bj)
#pragma unroll
                            for (int n = 0; n < 2; ++n) *(f32x4*)(sd + 32 * bj + 16 * n + 4 * fq) = v[bj][n];
                    }
                } else if (row < MV) {
                    const int nn = row - MPR;
                    if (kind == 0) { float* sd = (float*)(wsb + WS_QS) + ((size_t)nn * 20 + idx) * 64;
#pragma unroll
                        for (int bj = 0; bj < 2; ++bj)
#pragma unroll
                            for (int n = 0; n < 2; ++n) *(f32x4*)(sd + 32 * bj + 16 * n + 4 * fq) = v[bj][n];
                    } else { float* sd = dout + so_s + ((((size_t)nn * win + (win - 1)) * 2 + (kind - 1)) * H + hs) * 64;
#pragma unroll
                        for (int bj = 0; bj < 2; ++bj)
#pragma unroll
                            for (int n = 0; n < 2; ++n) *(f32x4*)(sd + 32 * bj + 16 * n + 4 * fq) = v[bj][n];
                    }
                }
            }
    }
};
template <int PASS> struct EpiUp {
    static constexpr bool PERM = true, AFTER_DRAIN = false;
    const bf16* G; float* MIXF; bf16* MIXB;
    __device__ __forceinline__ void operator()(const f32x4 (&acc)[2][2][4][2], const pg8::Unit& u, int wr, int wc, int fr, int fq) const {
        const int row0 = u.pm * 256 + wr * 64 + fr, col0 = u.pn * 256 + wc * 32 + 8 * fq;
#pragma unroll
        for (int ai = 0; ai < 2; ++ai)
#pragma unroll
            for (int m = 0; m < 4; ++m) { const int row = row0 + ai * 128 + m * 16;
#pragma unroll
                for (int bj = 0; bj < 2; ++bj) { const int col = col0 + bj * 128;
                    const u32x4 gw = *(const u32x4*)(G + (size_t)row * 2048 + PASS * 1024 + col);
                    f32x4 g0 = {bf2f(gw.x & 0xffff), bf2f(gw.x >> 16), bf2f(gw.y & 0xffff), bf2f(gw.y >> 16)}, g1 = {bf2f(gw.z & 0xffff), bf2f(gw.z >> 16), bf2f(gw.w & 0xffff), bf2f(gw.w >> 16)};
                    f32x4 v0 = acc[ai][bj][m][0] * g0, v1 = acc[ai][bj][m][1] * g1;
                    float* mp = MIXF + (size_t)row * DM + col;
                    if (PASS == 0) { *(f32x4*)mp = v0; *(f32x4*)(mp + 4) = v1; }
                    else { v0 = v0 + *(const f32x4*)mp; v1 = v1 + *(const f32x4*)(mp + 4);
                        u32x4 w; w.x = cvt_pk_bf16(v0[0], v0[1]); w.y = cvt_pk_bf16(v0[2], v0[3]); w.z = cvt_pk_bf16(v1[0], v1[1]); w.w = cvt_pk_bf16(v1[2], v1[3]);
                        *(u32x4*)(MIXB + (size_t)row * DM + col) = w; } } }
    }
};

__device__ __forceinline__ int crow_c(int r) { return (r & 3) + 8 * (r >> 2); }
__device__ __forceinline__ s16x4 vtr(const LAS unsigned char* p) { typedef short v4i16_t __attribute__((ext_vector_type(4))); return __builtin_bit_cast(s16x4, __builtin_amdgcn_ds_read_tr16_b64_v4i16((LAS v4i16_t*)p)); }

__device__ __forceinline__ void phase_attention(const Params& P, LAS unsigned char* lds) {
    const int tid = threadIdx.x, lane = tid & 63, wave = __builtin_amdgcn_readfirstlane(tid >> 6);
    unsigned char* ws = P.ws;
    const bf16* QP = (const bf16*)(ws + WS_QP); const bf16* KP = (const bf16*)(ws + WS_KP); const bf16* VP = (const bf16*)(ws + WS_VP);
    const float* QS = (const float*)(ws + WS_QS);
    bf16* OA = (bf16*)(ws + WS_OA); bf16* OB3 = (bf16*)(ws + WS_OB3); float* LSE3 = (float*)(ws + WS_LSE3);
    const float* sinks = P.in[16];
    {
        LAS float* pl = (LAS float*)(lds + ATT_PL) + wave * 192;
        for (int widx = blockIdx.x * 8 + wave; widx < NS * 20; widx += gridDim.x * 8) {
            const int n = widx / 20, hq = widx % 20;
            const float* cache; int H, L, dil, h; size_t so; int g = 0, slot = 0;
            if (hq < 8) { cache = P.in[2]; H = 2; L = 128; dil = 1; h = hq >> 2; so = O_AS; }
            else { const int jj = hq - 8; g = jj >> 2; slot = jj & 3; h = slot; H = 4; dil = 1 << (2 * g); L = 128 * dil; cache = (g > 1) ? P.in[5] : (g > 0 ? P.in[4] : P.in[3]); so = O_B1S + (g > 0 ? O_B2S - O_B1S : 0) + (g > 1 ? O_B3S - O_B2S : 0); }
            const float slope2 = exp2f(-0.4f * (float)(hq + 1)) * LOG2E * (float)dil;
            const float* newk = P.out + so + ((((size_t)n * L + (L - 1)) * 2 + 0) * H + h) * 64;
            const float* newv = newk + H * 64;
            const float* cb = cache + (size_t)n * L * 2 * H * 64;
            const f32x4* q4 = (const f32x4*)(QS + ((size_t)n * 20 + hq) * 64);
            float sv[3];
#pragma unroll
            for (int rd = 0; rd < 3; ++rd) {
                const int mm = lane + 64 * rd; const bool valid = mm <= 128; const int mc = valid ? mm : 0;
                const f32x4* k4 = (const f32x4*)((mc == 0) ? newk : cb + ((size_t)(L - dil * mc) * 2 * H + h) * 64);
                float dot = 0.f;
#pragma unroll
                for (int d = 0; d < 16; ++d) { const f32x4 a = q4[d], b = k4[d]; dot += (a[0] * b[0] + a[1] * b[1]) + (a[2] * b[2] + a[3] * b[3]); }
                sv[rd] = valid ? dot - slope2 * (float)mm : -1e30f;
            }
            float mx = wave_max(fmaxf(fmaxf(sv[0], sv[1]), sv[2]));
            float sink2 = 0.f;
            if (hq < 8) { sink2 = sinks[hq] * LOG2E; mx = fmaxf(mx, sink2); }
            float lsum = 0.f;
#pragma unroll
            for (int rd = 0; rd < 3; ++rd) { const float p = __builtin_amdgcn_exp2f(sv[rd] - mx); pl[lane + 64 * rd] = p; lsum += p; }
            lsum = wave_sum(lsum);
            if (hq < 8) lsum += __builtin_amdgcn_exp2f(sink2 - mx);
            asm volatile("s_waitcnt lgkmcnt(0)" ::: "memory");
            float o = pl[0] * newv[lane];
#pragma unroll 8
            for (int mm = 1; mm <= 128; ++mm) o += pl[mm] * cb[((size_t)(L - dil * mm) * 2 * H + H + h) * 64 + lane];
            o *= __builtin_amdgcn_rcpf(lsum);
            const size_t row = MPR + n;
            if (hq < 8) OA[row * 512 + hq * 64 + lane] = (bf16)(cvt_pk_bf16(o, 0.f) & 0xffff);
            else { OB3[((size_t)g * MP + row) * 256 + slot * 64 + lane] = (bf16)(cvt_pk_bf16(o, 0.f) & 0xffff); if (lane == 0) LSE3[((size_t)g * MP + row) * 4 + slot] = (mx + __builtin_amdgcn_logf(lsum)) * LN2; }
            asm volatile("s_waitcnt lgkmcnt(0)" ::: "memory");
        }
    }
    const int half = wave >> 2, w = wave & 3, r32 = lane & 31, hi = lane >> 5, htid = tid & 255;
    LAS unsigned char* Kl = lds + half * ATT_HALF; LAS unsigned char* Vl = Kl + 256 * ATT_KROW;
    for (int pair = blockIdx.x; pair < 2560; pair += gridDim.x) {
        const int it = 2 * pair + half, b = it / 320, rem = it % 320, hq = rem >> 4, j = rem & 15;
        int kidx, dil = 1, g = 0, slot = 0;
        if (hq < 8) kidx = hq >> 2; else { const int jj = hq - 8; g = jj >> 2; slot = jj & 3; kidx = 2 + jj; dil = 1 << (2 * g); }
        const int nblk = 16 / dil, blk = j & (nblk - 1), rres = j / nblk; const bool hasprev = blk != 0;
        const float sd = exp2f(-0.4f * (float)(hq + 1)) * LOG2E * (float)dil;
        const int krow0 = 128 * j - 128;
        const bf16* Kg = KP + ((size_t)(b * 14 + kidx) * 2048) * 64; const bf16* Vg = VP + ((size_t)(b * 14 + kidx) * 2048) * 64;
        const bf16* Qg = QP + ((size_t)(b * 20 + hq) * 2048 + 128 * j + 32 * w + r32) * 64 + hi * 8;
        bf16x8 qf[4];
#pragma unroll
        for (int d0 = 0; d0 < 4; ++d0) qf[d0] = *(const bf16x8*)(Qg + d0 * 16);
        u32x4 kreg[8], vreg[8];
#pragma unroll
        for (int c = 0; c < 8; ++c) { const int ch = htid + 256 * c; int grow = krow0 + (ch >> 3); grow = grow < 0 ? grow + 128 : grow; const size_t off = (size_t)grow * 64 + (ch & 7) * 8;
            kreg[c] = *(const u32x4*)(Kg + off); vreg[c] = *(const u32x4*)(Vg + off); }
        __syncthreads();
#pragma unroll
        for (int c = 0; c < 8; ++c) { const int ch = htid + 256 * c, row = ch >> 3, cc = ch & 7; *(LAS u32x4*)(Kl + row * ATT_KROW + cc * 16) = kreg[c]; *(LAS u32x4*)(Vl + row * ATT_KROW + cc * 16) = vreg[c]; }
        __syncthreads();
        f32x16 S[5];
#pragma unroll
        for (int kb = 0; kb < 5; ++kb) {
            S[kb] = (f32x16){0.f, 0.f, 0.f, 0.f, 0.f, 0.f, 0.f, 0.f, 0.f, 0.f, 0.f, 0.f, 0.f, 0.f, 0.f, 0.f};
            const LAS unsigned char* kp = Kl + (32 * w + 32 * kb + r32) * ATT_KROW + hi * 16;
#pragma unroll
            for (int d0 = 0; d0 < 4; ++d0) { const bf16x8 kf = *(const LAS bf16x8*)(kp + d0 * 32); S[kb] = __builtin_amdgcn_mfma_f32_32x32x16_bf16(kf, qf[d0], S[kb], 0, 0, 0); }
        }
        float mx = -1e30f;
#pragma unroll
        for (int kb = 0; kb < 5; ++kb)
#pragma unroll
            for (int r = 0; r < 16; ++r) { const int c = crow_c(r) + 4 * hi; const int dist = r32 + 128 - 32 * kb - c; const int ki = 32 * w + 32 * kb + c;
                bool ok = true; if (kb == 0) ok = dist <= 128; if (kb == 4) ok = dist >= 0; ok = ok && (hasprev || ki >= 128);
                const float v = ok ? S[kb][r] - sd * (float)dist : -1e30f; S[kb][r] = v; mx = fmaxf(mx, v); }
        mx = fmaxf(mx, __shfl_xor(mx, 32));
        float sink2 = 0.f;
        if (hq < 8) { sink2 = sinks[hq] * LOG2E; mx = fmaxf(mx, sink2); }
        float lsum = 0.f;
#pragma unroll
        for (int kb = 0; kb < 5; ++kb)
#pragma unroll
            for (int r = 0; r < 16; ++r) { const float p = __builtin_amdgcn_exp2f(S[kb][r] - mx); S[kb][r] = p; lsum += p; }
        lsum += __shfl_xor(lsum, 32);
        if (hq < 8) lsum += __builtin_amdgcn_exp2f(sink2 - mx);
        f32x16 o[2];
        o[0] = (f32x16){0.f, 0.f, 0.f, 0.f, 0.f, 0.f, 0.f, 0.f, 0.f, 0.f, 0.f, 0.f, 0.f, 0.f, 0.f, 0.f}; o[1] = o[0];
        const LAS unsigned char* vb = Vl + (32 * w + 4 * hi + ((lane & 15) >> 2)) * ATT_KROW + (16 * ((lane >> 4) & 1) + 4 * (lane & 3)) * 2;
#pragma unroll
        for (int kb = 0; kb < 5; ++kb)
#pragma unroll
            for (int kk = 0; kk < 2; ++kk) {
                u32x4 pw; pw.x = cvt_pk_bf16(S[kb][8 * kk + 0], S[kb][8 * kk + 1]); pw.y = cvt_pk_bf16(S[kb][8 * kk + 2], S[kb][8 * kk + 3]); pw.z = cvt_pk_bf16(S[kb][8 * kk + 4], S[kb][8 * kk + 5]); pw.w = cvt_pk_bf16(S[kb][8 * kk + 6], S[kb][8 * kk + 7]);
                const bf16x8 pf = __builtin_bit_cast(bf16x8, pw);
#pragma unroll
                for (int dh = 0; dh < 2; ++dh) {
                    const LAS unsigned char* vp = vb + (32 * kb + 16 * kk) * ATT_KROW + dh * 64;
                    const s16x4 lo = vtr(vp), hh = vtr(vp + 8 * ATT_KROW);
                    const bf16x8 vf = {lo[0], lo[1], lo[2], lo[3], hh[0], hh[1], hh[2], hh[3]};
                    o[dh] = __builtin_amdgcn_mfma_f32_32x32x16_bf16(vf, pf, o[dh], 0, 0, 0);
                }
            }
        const float inv = __builtin_amdgcn_rcpf(lsum);
        const int sq = (blk * 128 + 32 * w + r32) * dil + rres; const size_t row = (size_t)b * 2048 + sq;
        bf16* dst = (hq < 8) ? OA + row * 512 + hq * 64 : OB3 + ((size_t)g * MP + row) * 256 + slot * 64;
#pragma unroll
        for (int dh = 0; dh < 2; ++dh)
#pragma unroll
            for (int c = 0; c < 4; ++c) { u32x2 wv; wv.x = cvt_pk_bf16(o[dh][4 * c] * inv, o[dh][4 * c + 1] * inv); wv.y = cvt_pk_bf16(o[dh][4 * c + 2] * inv, o[dh][4 * c + 3] * inv);
                *(u32x2*)(dst + 32 * dh + 8 * c + 4 * hi) = wv; }
        if (hq >= 8 && hi == 0) LSE3[((size_t)g * MP + row) * 4 + slot] = (mx + __builtin_amdgcn_logf(lsum)) * LN2;
    }
    __syncthreads();
}

__device__ __forceinline__ void phase_merge(const Params& P) {
    unsigned char* ws = P.ws;
    const bf16* OB3 = (const bf16*)(ws + WS_OB3); const float* LSE3 = (const float*)(ws + WS_LSE3); bf16* OBM = (bf16*)(ws + WS_OBM);
    const long gtid = (long)blockIdx.x * 512 + threadIdx.x, gthreads = (long)gridDim.x * 512;
    for (long i = gtid; i < (long)MV * 32; i += gthreads) {
        const long row = i >> 5; const int ch = (int)(i & 31), slot = ch >> 3;
        float l[3], mx = -1e30f;
#pragma unroll
        for (int g = 0; g < 3; ++g) { l[g] = LSE3[((size_t)g * MP + row) * 4 + slot]; mx = fmaxf(mx, l[g]); }
        float wsum = 0.f;
#pragma unroll
        for (int g = 0; g < 3; ++g) { l[g] = __builtin_amdgcn_exp2f((l[g] - mx) * LOG2E); wsum += l[g]; }
        const float inv = __builtin_amdgcn_rcpf(wsum);
        float a[8] = {0.f, 0.f, 0.f, 0.f, 0.f, 0.f, 0.f, 0.f};
#pragma unroll
        for (int g = 0; g < 3; ++g) { const u32x4 v = *(const u32x4*)(OB3 + ((size_t)g * MP + row) * 256 + ch * 8); const float wg = l[g] * inv;
            a[0] += wg * bf2f(v.x & 0xffff); a[1] += wg * bf2f(v.x >> 16); a[2] += wg * bf2f(v.y & 0xffff); a[3] += wg * bf2f(v.y >> 16);
            a[4] += wg * bf2f(v.z & 0xffff); a[5] += wg * bf2f(v.z >> 16); a[6] += wg * bf2f(v.w & 0xffff); a[7] += wg * bf2f(v.w >> 16); }
        u32x4 o; o.x = cvt_pk_bf16(a[0], a[1]); o.y = cvt_pk_bf16(a[2], a[3]); o.z = cvt_pk_bf16(a[4], a[5]); o.w = cvt_pk_bf16(a[6], a[7]);
        *(u32x4*)(OBM + row * 256 + ch * 8) = o;
    }
}

#define GEMM_PHASE(EPI, A_, B_, N_, K_, E_) do { pg8::Gemm g_{(const bf16*)(A_), (const bf16*)(B_), MP, (N_), (K_)}; pg8::StaticOrder S_; S_.init(MP, (N_), (int)gridDim.x, (int)blockIdx.x); \
    pg8::gemm_phase<EPI, pg8::StaticOrder, true, true>(lds, g_, S_, E_); } while (0)

__global__ void __launch_bounds__(512, 2) mega_fwd(Params P) {
    extern __shared__ __attribute__((aligned(16))) unsigned char lds_raw[];
    LAS unsigned char* lds = (LAS unsigned char*)lds_raw;
    cg::grid_group grid = cg::this_grid();
    unsigned char* ws = P.ws;
    float* ss1 = (float*)(ws + WS_SS1); float* ss2 = (float*)(ws + WS_SS2); float* ss3 = (float*)(ws + WS_SS3);
    float* X1 = (float*)(ws + WS_X1);
    phase_prologue(P, lds);
    grid.sync();
    { EpiSwiGLU E{(bf16*)(ws + WS_H), ss1}; GEMM_PHASE(EpiSwiGLU, ws + WS_XB, ws + WS_W1GU, 2 * DFF, DM, E); }
    grid.sync();
    { EpiRes E{P.in[0], P.in[1], X1, (bf16*)(ws + WS_X1B), ss2, 0.5f}; GEMM_PHASE(EpiRes, ws + WS_H, ws + WS_W1D, DM, DFF, E); }
    grid.sync();
    { EpiQKV E{ss2, ws, (bf16*)(ws + WS_G), P.out, (const float*)(ws + WS_GT)};
      GEMM_PHASE(EpiQKV, ws + WS_X1B, ws + WS_WIN, INW, DM, E); }
    grid.sync();
    phase_attention(P, lds);
    grid.sync();
    phase_merge(P);
    grid.sync();
    { EpiUp<0> E{(const bf16*)(ws + WS_G), (float*)(ws + WS_MIXF), (bf16*)(ws + WS_MIXB)}; GEMM_PHASE(EpiUp<0>, ws + WS_OA, ws + WS_WUA, DM, 512, E); }
    { EpiUp<1> E{(const bf16*)(ws + WS_G), (float*)(ws + WS_MIXF), (bf16*)(ws + WS_MIXB)}; GEMM_PHASE(EpiUp<1>, ws + WS_OBM, ws + WS_WUB, DM, 256, E); }
    grid.sync();
    { EpiRes E{X1, X1 + (size_t)MPR * DM, X1, (bf16*)(ws + WS_X2B), ss3, 1.0f}; GEMM_PHASE(EpiRes, ws + WS_MIXB, ws + WS_WO, DM, DM, E); }
    grid.sync();
    { EpiSwiGLU E{(bf16*)(ws + WS_H), ss3}; GEMM_PHASE(EpiSwiGLU, ws + WS_X2B, ws + WS_W2GU, 2 * DFF, DM, E); }
    grid.sync();
    { EpiRes E{X1, X1 + (size_t)MPR * DM, P.out, nullptr, nullptr, 0.5f}; GEMM_PHASE(EpiRes, ws + WS_H, ws + WS_W2D, DM, DFF, E); }
}

extern "C" void kernel_launch(void* const* d_in, const int* in_sizes, int n_in, void* d_out, int out_size, void* d_ws, size_t ws_size, hipStream_t stream) {
    static int grid = 0;
    if (grid == 0) {
        if (n_in != 24 || ws_size < WS_END) { fprintf(stderr, "kernel_launch: unexpected n_in %d / ws_size %zu\n", n_in, ws_size); grid = -1; return; }
        int dev = 0, cus = 0, per_cu = 0;
        hipGetDevice(&dev); hipDeviceGetAttribute(&cus, hipDeviceAttributeMultiprocessorCount, dev);
        if (hipFuncSetAttribute((const void*)mega_fwd, hipFuncAttributeMaxDynamicSharedMemorySize, LDS_BYTES) != hipSuccess) { fprintf(stderr, "kernel_launch: hipFuncSetAttribute failed\n"); grid = -1; return; }
        if (hipOccupancyMaxActiveBlocksPerMultiprocessor(&per_cu, (const void*)mega_fwd, 512, LDS_BYTES) != hipSuccess || per_cu < 1) { fprintf(stderr, "kernel_launch: occupancy query says %d\n", per_cu); per_cu = 1; }
        (void)hipGetLastError();
        grid = cus * per_cu;
        fprintf(stderr, "kernel_launch: grid %d (cus %d x %d)\n", grid, cus, per_cu);
    }
    if (grid < 0) return;
    Params p{};
    for (int i = 0; i < 24; ++i) p.in[i] = (const float*)d_in[i];
    p.out = (float*)d_out; p.ws = (unsigned char*)d_ws;
    void* args[] = {&p};
    hipError_t e = hipLaunchCooperativeKernel((const void*)mega_fwd, dim3(grid), dim3(512), args, LDS_BYTES, stream);
    if (e != hipSuccess) fprintf(stderr, "cooperative launch failed: %s (grid %d)\n", hipGetErrorString(e), grid);
}
```

```cpp
#include <hip/hip_runtime.h>
#include <hip/hip_cooperative_groups.h>
#include <cstdio>
#include <cstdint>
#include <type_traits>
namespace cg = cooperative_groups;
namespace pg8 {
#define PG8_LAS __attribute__((address_space(3)))
typedef unsigned short bf16_t;
typedef short bf16x8 __attribute__((ext_vector_type(8)));
typedef float f32x4 __attribute__((ext_vector_type(4)));
typedef unsigned u32x4 __attribute__((ext_vector_type(4)));
constexpr int BM = 256, BK = 64, HALF = 128, HTB = HALF * BK * 2  , STAGE_BYTES = 8 * HTB, NXCD = 8, WGM = 8;

__host__ __device__ __forceinline__ int lds_byte(int r, int c) { const int st = (r >> 4) * 2 + (c >> 5), rr = r & 15, cc = c & 31, ob = rr * 64 + cc * 2; return st * 1024 + (ob ^ (((ob >> 9) & 1) << 5)); }
__host__ __device__ __forceinline__ void stage_rc(int b, int& R, int& C) { const int st = b / 1024, sb = b % 1024, swz = sb ^ (((sb >> 9) & 1) << 5); R = (st >> 1) * 16 + swz / 64; C = (st & 1) * 32 + (swz % 64) / 2; }
__host__ __device__ __forceinline__ int perm32(int rho) { const int n = rho >> 4, i = rho & 15; return 8 * (i >> 2) + 4 * n + (i & 3); }

struct Unit { int pm, pn, kt0, nt, split; };
struct Gemm { const bf16_t* A; const bf16_t* Bt; int M, N, K; };

struct StaticOrder {
    int nM, nN, nwg, G, c;
    __host__ __device__ void init(int M, int N, int G_, int c_) { nM = M / BM; nN = N / BM; nwg = nM * nN; G = G_; c = c_; }
    __host__ __device__ bool next(int i, Unit& u) const {
        const long L = (long)i * G + c; if (L >= nwg) return false;
        int wgid = (int)L; { const int q = nwg / NXCD, r = nwg % NXCD, xcd = wgid % NXCD, off = wgid / NXCD; wgid = (xcd < r ? xcd * (q + 1) : r * (q + 1) + (xcd - r) * q) + off; }
        const int nig = WGM * nN, gid = wgid / nig, fm = gid * WGM, gsz = (nM - fm) < WGM ? (nM - fm) : WGM;
        u.pm = fm + ((wgid % nig) % gsz); u.pn = (wgid % nig) / gsz; u.kt0 = 0; u.nt = ntK; u.split = 1; return true;
    }
    __device__ __forceinline__ void a_ready(const Unit&) const {}
    __device__ __forceinline__ void done(const Unit&) const {}
    int ntK; float* acc_buf; unsigned* cnt;
};
struct SplitOrder {
    StaticOrder so; int nmain, ntot, S, ntK; float* acc_buf; unsigned* cnt;
    __host__ __device__ void init(int N, int K, int G_, int c_, int S_, float* ab, unsigned* cn) { so.init(128 * BM, N, G_, c_); so.ntK = K / BK; nmain = so.nwg; S = S_; ntK = K / BK; ntot = nmain + so.nN * S; acc_buf = ab; cnt = cn; }
    __host__ __device__ __forceinline__ bool next(int i, Unit& u) const {
        const long L = (long)i * so.G + so.c; if (L >= ntot) return false;
        int pm, pn, kt0 = 0, n = ntK, sp = 1;
        if (L < nmain) {
            int wgid = (int)L; { const int nwg = nmain, q = nwg / NXCD, r = nwg % NXCD, xcd = wgid % NXCD, off = wgid / NXCD; wgid = (xcd < r ? xcd * (q + 1) : r * (q + 1) + (xcd - r) * q) + off; }
            const int nig = WGM * so.nN, gid = wgid / nig, fm = gid * WGM, gsz = (128 - fm) < WGM ? (128 - fm) : WGM;
            pm = fm + ((wgid % nig) % gsz); pn = (wgid % nig) / gsz;
        } else { const int e = (int)L - nmain; pm = 128; pn = e / S; n = ntK / S; kt0 = (e - pn * S) * n; sp = S; }
        u.pm = pm; u.pn = pn; u.kt0 = kt0; u.nt = n; u.split = sp; return true;
    }
    __device__ __forceinline__ void a_ready(const Unit&) const {}
    __device__ __forceinline__ void done(const Unit&) const {}
};

__device__ __forceinline__ unsigned cvt_pk_bf16(float lo, float hi) { unsigned r; asm volatile("v_cvt_pk_bf16_f32 %0, %1, %2" : "=v"(r) : "v"(lo), "v"(hi)); return r; }
typedef float f32x2 __attribute__((ext_vector_type(2)));
struct BgNone { static constexpr unsigned PER = 0; };
template <unsigned PER_, unsigned LR4_, unsigned R4_> struct BgCopy { static constexpr unsigned PER = PER_, LR4 = LR4_, R4 = R4_; const f32x4* src; f32x4* dst; f32x4* dump; unsigned lo, hi; int rounds; };
template <class Epi, class Sched, bool ALIGN_EPI = false, bool SP2 = false, class Bg = BgNone>
__device__ __forceinline__ void gemm_phase(PG8_LAS unsigned char* lds, const Gemm g, const Sched& S, const Epi& E, const int wave_sg, const Bg& bg = Bg()) {
    int tid_; asm volatile("v_mbcnt_lo_u32_b32 %0, -1, 0\n\tv_mbcnt_hi_u32_b32 %0, -1, %0\n\tv_lshl_or_b32 %0, %1, 6, %0" : "=&v"(tid_) : "s"(wave_sg));
    const int tid = tid_, wid = __builtin_amdgcn_readfirstlane(tid >> 6), lane = tid & 63, wr = wid >> 2, wc = wid & 3, fr = lane & 15, fq = lane >> 4;
    const int K = g.K, nt = K / BK;
    unsigned voffA[2], voffB[2];
#pragma unroll
    for (int i = 0; i < 2; ++i) { int R, C; stage_rc(tid * 16 + i * 8192, R, C); const int Rb = Epi::PERM ? ((R & ~31) + perm32(R & 31)) : R;
        voffA[i] = (unsigned)(R * K + C) * 2u; voffB[i] = (unsigned)(Rb * K + C) * 2u; }
    const size_t kstep = (size_t)(BK * 2);
    const size_t hstep = (size_t)HALF * K * 2;
    const size_t tstep = 2 * hstep;
    const unsigned ldsw = (unsigned)wid * 1024u;
    const int aoff = lds_byte(wr * 64 + fr, fq * 8), boff = lds_byte(wc * 32 + fr, fq * 8);
#define PG8_SA(b, h) (((b) * 2 + (h)) * HTB)
#define PG8_SB(b, h) ((4 + (b) * 2 + (h)) * HTB)
#define PG8_STAGE(bufoff, gbase, voff) do { _Pragma("unroll") for (int _i = 0; _i < 2; ++_i) \
        __builtin_amdgcn_global_load_lds((const unsigned*)((const char*)(gbase) + (voff)[_i]), (PG8_LAS unsigned*)(lds + (bufoff) + ldsw + _i * 8192), 16, 0, 0); } while (0)
#define PG8_LDA(dst, b, h) do { _Pragma("unroll") for (int m = 0; m < 4; ++m) _Pragma("unroll") for (int k = 0; k < 2; ++k) dst[m][k] = *(const PG8_LAS bf16x8*)(lds + PG8_SA(b, h) + aoff + m * 2048 + k * 1024); } while (0)
#define PG8_LDB(dst, b, h) do { _Pragma("unroll") for (int n = 0; n < 2; ++n) _Pragma("unroll") for (int k = 0; k < 2; ++k) dst[n][k] = *(const PG8_LAS bf16x8*)(lds + PG8_SB(b, h) + boff + n * 2048 + k * 1024); } while (0)
#define PG8_MMA(ai, bj, At, Bt) do { __builtin_amdgcn_s_setprio(1); _Pragma("unroll") for (int m = 0; m < 4; ++m) _Pragma("unroll") for (int n = 0; n < 2; ++n) _Pragma("unroll") for (int k = 0; k < 2; ++k) \
        acc[ai][bj][m][n] = __builtin_amdgcn_mfma_f32_16x16x32_bf16(Bt[n][k], At[m][k], acc[ai][bj][m][n], 0, 0, 0); __builtin_amdgcn_s_setprio(0); } while (0)
#define PG8_WAIT_V(n) asm volatile("s_waitcnt vmcnt(" #n ")" ::: "memory")
#define PG8_WAIT_L(n) asm volatile("s_waitcnt lgkmcnt(" #n ")" ::: "memory")
#define PG8_BAR __builtin_amdgcn_s_barrier()
#define PG8_SCHED __builtin_amdgcn_sched_barrier(0)
    Unit cur, nxt; int ui = 0;
    f32x4 bgdata = {0.f, 0.f, 0.f, 0.f}; f32x4* bgdst = nullptr;
    if constexpr (Bg::PER != 0) bgdst = bg.dump + (size_t)blockIdx.x * 512 + tid;
    if (!S.next(0, cur)) return;
    f32x4 acc[2][2][4][2];
#pragma unroll
    for (int a = 0; a < 2; ++a)
#pragma unroll
        for (int b = 0; b < 2; ++b)
#pragma unroll
            for (int m = 0; m < 4; ++m)
#pragma unroll
                for (int n = 0; n < 2; ++n) acc[a][b][m][n] = (f32x4){0.f, 0.f, 0.f, 0.f};
    bf16x8 At[4][2], B0[2][2], B1[2][2];
    const char* cA = (const char*)g.A + (size_t)cur.pm * tstep + (size_t)cur.kt0 * kstep; const char* cB = (const char*)g.Bt + (size_t)cur.pn * tstep + (size_t)cur.kt0 * kstep;
    S.a_ready(cur);
    if constexpr (SP2) {
        PG8_STAGE(PG8_SB(0, 0), cB, voffB); PG8_STAGE(PG8_SB(0, 1), cB + hstep, voffB); PG8_STAGE(PG8_SA(0, 0), cA, voffA); PG8_STAGE(PG8_SA(0, 1), cA + hstep, voffA);
        if (wr == 1) PG8_BAR;
        PG8_WAIT_V(2); PG8_BAR;
        PG8_STAGE(PG8_SB(1, 0), cB + kstep, voffB); PG8_STAGE(PG8_SA(1, 0), cA + kstep, voffA); PG8_STAGE(PG8_SB(1, 1), cB + hstep + kstep, voffB);
        PG8_WAIT_V(6); PG8_BAR;
    } else {
        PG8_STAGE(PG8_SB(0, 0), cB, voffB); PG8_STAGE(PG8_SA(0, 0), cA, voffA); PG8_STAGE(PG8_SB(0, 1), cB + hstep, voffB); PG8_STAGE(PG8_SA(0, 1), cA + hstep, voffA);
        if (wr == 1) PG8_BAR;
        PG8_WAIT_V(4); PG8_BAR;
        PG8_STAGE(PG8_SB(1, 0), cB + kstep, voffB); PG8_STAGE(PG8_SA(1, 0), cA + kstep, voffA); PG8_STAGE(PG8_SB(1, 1), cB + hstep + kstep, voffB);
        PG8_WAIT_V(6); PG8_BAR;
    }
    for (;;) {
        const bool has_next = S.next(ui + 1, nxt);
        const char* nA = has_next ? (const char*)g.A + (size_t)nxt.pm * tstep + (size_t)nxt.kt0 * kstep : cA; const char* nB = has_next ? (const char*)g.Bt + (size_t)nxt.pn * tstep + (size_t)nxt.kt0 * kstep : cB;
        const int cnt_ = cur.nt;
        for (int t = 0; t < cnt_; t += 2) {
            if constexpr (Epi::HOOK_T >= 0) { if (t == Epi::HOOK_T) E.hook(acc, cur, wr, wc, fr, fq); }
            const bool last = (t == cnt_ - 2);
            const char* a1 = cA + (size_t)(t + 1) * kstep;
            const char* a2 = last ? nA : cA + (size_t)(t + 2) * kstep; const char* b2 = last ? nB : cB + (size_t)(t + 2) * kstep;
            const char* a3 = a2 + kstep; const char* b3 = b2 + kstep;
            if (last && has_next) S.a_ready(nxt);
            if constexpr (SP2) {
            bool bg_on = false;
            if constexpr (Bg::PER != 0) { bg_on = ui < bg.rounds;
                if (bg_on) {
                    const unsigned idx = bg.lo + (unsigned)((ui * (nt >> 1) + (t >> 1)) * (int)gridDim.x + (int)blockIdx.x) * 512u + (unsigned)tid; const bool ok = idx < bg.hi;
                    const unsigned n = idx / Bg::PER, j = idx - n * Bg::PER; const size_t so = (size_t)n * Bg::LR4 + j;
                    const f32x4* sp = ok ? bg.src + so + Bg::R4 : bg.src; f32x4* nd = ok ? bg.dst + so : bg.dump + (size_t)blockIdx.x * 512 + tid;
                    asm volatile("global_store_dwordx4 %1, %0, off nt\n\tglobal_load_dwordx4 %0, %2, off nt" : "+v"(bgdata) : "v"(bgdst), "v"(sp) : "memory");
                    bgdst = nd; } }
            PG8_LDB(B0, 0, 0); PG8_LDB(B1, 0, 1); PG8_SCHED; PG8_LDA(At, 0, 0); PG8_STAGE(PG8_SA(1, 1), a1 + hstep, voffA);
            if (bg_on) { PG8_WAIT_V(10); } else { PG8_WAIT_V(8); } PG8_WAIT_L(0); PG8_BAR; PG8_MMA(0, 0, At, B0); PG8_MMA(0, 1, At, B1); PG8_BAR; PG8_SCHED;
            PG8_LDA(At, 0, 1); PG8_STAGE(PG8_SB(0, 0), b2, voffB); PG8_STAGE(PG8_SB(0, 1), b2 + hstep, voffB); PG8_STAGE(PG8_SA(0, 0), a2, voffA);
            if (bg_on) { PG8_WAIT_V(10); } else { PG8_WAIT_V(8); } PG8_WAIT_L(0); PG8_BAR; PG8_MMA(1, 0, At, B0); PG8_MMA(1, 1, At, B1); PG8_BAR; PG8_SCHED;
            PG8_LDB(B0, 1, 0); PG8_LDB(B1, 1, 1); PG8_SCHED; PG8_LDA(At, 1, 0); PG8_STAGE(PG8_SA(0, 1), a2 + hstep, voffA);
            PG8_WAIT_V(8); PG8_WAIT_L(0); PG8_BAR; PG8_MMA(0, 0, At, B0); PG8_MMA(0, 1, At, B1); PG8_BAR; PG8_SCHED;
            PG8_LDA(At, 1, 1); PG8_STAGE(PG8_SB(1, 0), b3, voffB); PG8_STAGE(PG8_SB(1, 1), b3 + hstep, voffB); PG8_STAGE(PG8_SA(1, 0), a3, voffA);
            PG8_WAIT_V(8); PG8_WAIT_L(0); PG8_BAR; PG8_MMA(1, 0, At, B0); PG8_MMA(1, 1, At, B1); PG8_BAR; PG8_SCHED;
            } else {
            PG8_LDB(B0, 0, 0); PG8_SCHED; PG8_LDA(At, 0, 0); PG8_STAGE(PG8_SA(1, 1), a1 + hstep, voffA);
            PG8_WAIT_L(8); PG8_BAR; PG8_WAIT_L(0); PG8_MMA(0, 0, At, B0); PG8_BAR; PG8_SCHED;
            PG8_LDB(B1, 0, 1); PG8_STAGE(PG8_SB(0, 0), b2, voffB);
            PG8_BAR; PG8_WAIT_L(0); PG8_MMA(0, 1, At, B1); PG8_BAR;
            PG8_LDA(At, 0, 1); PG8_STAGE(PG8_SA(0, 0), a2, voffA);
            PG8_BAR; PG8_WAIT_L(0); PG8_MMA(1, 0, At, B0); PG8_BAR; PG8_SCHED;
            PG8_STAGE(PG8_SB(0, 1), b2 + hstep, voffB);
            PG8_WAIT_V(6); PG8_BAR; PG8_MMA(1, 1, At, B1); PG8_BAR;
            PG8_LDB(B0, 1, 0); PG8_SCHED; PG8_LDA(At, 1, 0); PG8_STAGE(PG8_SA(0, 1), a2 + hstep, voffA);
            PG8_WAIT_L(8); PG8_BAR; PG8_WAIT_L(0); PG8_MMA(0, 0, At, B0); PG8_BAR; PG8_SCHED;
            PG8_LDB(B1, 1, 1); PG8_STAGE(PG8_SB(1, 0), b3, voffB);
            PG8_BAR; PG8_WAIT_L(0); PG8_MMA(0, 1, At, B1); PG8_BAR;
            PG8_LDA(At, 1, 1); PG8_STAGE(PG8_SA(1, 0), a3, voffA);
            PG8_BAR; PG8_WAIT_L(0); PG8_MMA(1, 0, At, B0); PG8_BAR; PG8_SCHED;
            PG8_STAGE(PG8_SB(1, 1), b3 + hstep, voffB);
            PG8_WAIT_V(6); PG8_BAR; PG8_MMA(1, 1, At, B1); PG8_BAR;
            }
        }
        if constexpr (ALIGN_EPI) { if (wr == 0) PG8_BAR; }
        if (cur.split > 1) {
            float* ab = S.acc_buf + (size_t)cur.pn * (64 * 512) + tid;
#pragma unroll
            for (int m = 0; m < 4; ++m)
#pragma unroll
                for (int bj = 0; bj < 2; ++bj)
#pragma unroll
                    for (int n = 0; n < 2; ++n)
#pragma unroll
                        for (int c = 0; c < 4; ++c) unsafeAtomicAdd(ab + (((m * 2 + bj) * 2 + n) * 4 + c) * 512, acc[0][bj][m][n][c]);
            __threadfence();
            PG8_LAS unsigned* flag = (PG8_LAS unsigned*)(lds + STAGE_BYTES);
            PG8_BAR;
            if (tid == 0) { const unsigned old = __hip_atomic_fetch_add(S.cnt + cur.pn, 1u, __ATOMIC_ACQ_REL, __HIP_MEMORY_SCOPE_AGENT); *flag = (old == (unsigned)cur.split - 1u) ? 1u : 0u; }
            asm volatile("s_waitcnt lgkmcnt(0)" ::: "memory"); PG8_BAR; asm volatile("" ::: "memory");
            const bool lastone = *flag != 0u;
            asm volatile("s_waitcnt lgkmcnt(0)" ::: "memory"); PG8_BAR;
            if (lastone) { __threadfence();
#pragma unroll
                for (int m = 0; m < 4; ++m)
#pragma unroll
                    for (int bj = 0; bj < 2; ++bj)
#pragma unroll
                        for (int n = 0; n < 2; ++n) {
#pragma unroll
                            for (int c = 0; c < 4; ++c) acc[0][bj][m][n][c] = __hip_atomic_load(ab + (((m * 2 + bj) * 2 + n) * 4 + c) * 512, __ATOMIC_RELAXED, __HIP_MEMORY_SCOPE_AGENT);
                            acc[1][bj][m][n] = (f32x4){0.f, 0.f, 0.f, 0.f}; }
                E(acc, cur, wr, wc, fr, fq); }
        } else
        if constexpr (!Epi::AFTER_DRAIN) { E(acc, cur, wr, wc, fr, fq); S.done(cur); }
        if (!has_next) break;
#pragma unroll
        for (int a = 0; a < 2; ++a)
#pragma unroll
            for (int b = 0; b < 2; ++b)
#pragma unroll
                for (int m = 0; m < 4; ++m)
#pragma unroll
                    for (int n = 0; n < 2; ++n) acc[a][b][m][n] = (f32x4){0.f, 0.f, 0.f, 0.f};
        cur = nxt; cA = nA; cB = nB; ++ui;
        if constexpr (ALIGN_EPI) { if (wr == 1) PG8_BAR; }
    }
    if constexpr (Bg::PER != 0) { if (bg.rounds > 0) asm volatile("global_store_dwordx4 %1, %0, off nt" :: "v"(bgdata), "v"(bgdst) : "memory"); }
    PG8_WAIT_V(0);
    if constexpr (!ALIGN_EPI) { if (wr == 0) PG8_BAR; }
    PG8_BAR;
    if constexpr (Epi::AFTER_DRAIN) { E.fused(acc, cur, wr, wc, fr, fq, lds, wid, lane); S.done(cur); }
#undef PG8_SA
#undef PG8_SB
#undef PG8_STAGE
#undef PG8_LDA
#undef PG8_LDB
#undef PG8_MMA
#undef PG8_WAIT_V
#undef PG8_WAIT_L
#undef PG8_BAR
#undef PG8_SCHED
}
}

#ifndef PG8_SP2
#define PG8_SP2 true
#endif
#define LAS __attribute__((address_space(3)))
typedef unsigned short bf16;
typedef pg8::f32x4 f32x4;
typedef pg8::u32x4 u32x4;
typedef pg8::bf16x8 bf16x8;
typedef unsigned u32x2 __attribute__((ext_vector_type(2)));
typedef float f32x16 __attribute__((ext_vector_type(16)));
typedef short s16x4 __attribute__((ext_vector_type(4)));
using pg8::cvt_pk_bf16;

constexpr int DM = 1024, DFF = 2816, SEQ = 2048, MPR = 32768, NS = 128, MV = MPR + NS, MP = 33024, INW = 5120;
constexpr float EPS = 1e-6f;
constexpr float LOG2E = 1.4426950408889634f, LN2 = 0.6931471805599453f;
constexpr float QSCALE = 0.125f * LOG2E;
constexpr size_t MiB = 1u << 20;
constexpr size_t WS_SS1 = 0, WS_SS2 = 256 * 1024, WS_SS3 = 512 * 1024, WS_GT = 768 * 1024;
constexpr size_t WS_W1GU = 1 * MiB, WS_W1D = 13 * MiB, WS_WIN = 19 * MiB, WS_WUA = 29 * MiB, WS_WUB = 30 * MiB, WS_WO = 31 * MiB, WS_W2GU = 33 * MiB, WS_W2D = 45 * MiB;
constexpr size_t WS_XB = 52 * MiB, WS_H = 117 * MiB, WS_X1 = 295 * MiB, WS_X1B = 424 * MiB, WS_QP = 489 * MiB, WS_KP = 569 * MiB, WS_VP = 625 * MiB, WS_QS = 681 * MiB;
constexpr size_t WS_G = 682 * MiB, WS_XAB = 912 * MiB, WS_OB3 = 844 * MiB, WS_LSE3 = 893 * MiB, WS_MIXB = 1041 * MiB, WS_X2B = 1106 * MiB, WS_DUMP = 1171 * MiB, WS_ACC = 1174 * MiB, WS_END = 1176 * MiB;
constexpr size_t ACC_FLOATS = 4 * 64 * 512;
constexpr size_t O_YP = 0, O_YS = 33554432, O_AP = 33685504, O_B1P = 34209792, O_B2P = 35258368, O_B3P = 39452672, O_AS = 56229888, O_B1S = 60424192, O_B2S = 68812800, O_B3S = 102367232;

constexpr int ATT_KROW = 144, ATT_HALF = 2 * 256 * ATT_KROW, ATT_PL = 2 * ATT_HALF;
constexpr int LDS_BYTES = ATT_PL + 8 * 1024;

__device__ __forceinline__ int tid_now_(int wave_sg) { int t; asm volatile("v_mbcnt_lo_u32_b32 %0, -1, 0\n\tv_mbcnt_hi_u32_b32 %0, -1, %0\n\tv_lshl_or_b32 %0, %1, 6, %0" : "=&v"(t) : "s"(wave_sg)); return t; }
#define TID_NOW(wave_sg) tid_now_(wave_sg)
struct Params {
    const float* in[24];
    float* out;
    unsigned char* ws;
};
typedef const __attribute__((address_space(4))) Params* KParams;

__device__ __forceinline__ float wave_sum(float v) {
#pragma unroll
    for (int o = 1; o < 64; o <<= 1) v += __shfl_xor(v, o);
    return v;
}
__device__ __forceinline__ float wave_max(float v) {
#pragma unroll
    for (int o = 1; o < 64; o <<= 1) v = fmaxf(v, __shfl_xor(v, o));
    return v;
}
__device__ __forceinline__ float bf2f(unsigned short b) { return __builtin_bit_cast(float, (unsigned)b << 16); }
__device__ __forceinline__ float sigmoidf_(float x) { return __builtin_amdgcn_rcpf(1.f + __builtin_amdgcn_exp2f(-x * LOG2E)); }

__device__ __forceinline__ void tr_item(const float* __restrict__ W, int ldw, int k0, int ns0, bf16* WT, int K, int nd0, const float* __restrict__ gain, LAS float* scr, int lane) {
#pragma unroll 16
    for (int i = 0; i < 32; ++i) { const int kk = 2 * i + (lane >> 5); float w = W[(size_t)(k0 + kk) * ldw + ns0 + (lane & 31)]; if (gain) w *= gain[k0 + kk]; scr[kk * 33 + (lane & 31)] = w; }
    asm volatile("s_waitcnt lgkmcnt(0)" ::: "memory");
    const int c = lane & 7;
#pragma unroll
    for (int j = 0; j < 4; ++j) { const int n = (lane >> 3) + 8 * j; const LAS float* s = scr + (8 * c) * 33 + n;
        u32x4 o; o.x = cvt_pk_bf16(s[0 * 33], s[1 * 33]); o.y = cvt_pk_bf16(s[2 * 33], s[3 * 33]); o.z = cvt_pk_bf16(s[4 * 33], s[5 * 33]); o.w = cvt_pk_bf16(s[6 * 33], s[7 * 33]);
        *(u32x4*)(WT + (size_t)(nd0 + n) * K + k0 + 8 * c) = o; }
    asm volatile("s_waitcnt lgkmcnt(0)" ::: "memory");
}
template <int L, int R> __device__ __forceinline__ void copy_seg(const float* __restrict__ src, float* __restrict__ dst, unsigned lo, unsigned hi, unsigned t0, unsigned nthr) {
    constexpr unsigned PER = (unsigned)(L - 1) * R / 4, LR4 = (unsigned)L * R / 4, R4 = R / 4;
    const f32x4* s4 = (const f32x4*)src; f32x4* d4 = (f32x4*)dst;
    unsigned i = lo + t0;
    for (; i + 3 * nthr < hi; i += 4 * nthr) {
        f32x4 v[4];
#pragma unroll
        for (int u = 0; u < 4; ++u) { const unsigned ii = i + u * nthr, n = ii / PER, j = ii - n * PER; v[u] = __builtin_nontemporal_load(s4 + (size_t)n * LR4 + R4 + j); }
#pragma unroll
        for (int u = 0; u < 4; ++u) { const unsigned ii = i + u * nthr, n = ii / PER, j = ii - n * PER; __builtin_nontemporal_store(v[u], d4 + (size_t)n * LR4 + j); }
    }
    for (; i < hi; i += nthr) { const unsigned n = i / PER, j = i - n * PER; __builtin_nontemporal_store(__builtin_nontemporal_load(s4 + (size_t)n * LR4 + R4 + j), d4 + (size_t)n * LR4 + j); }
}
constexpr unsigned CP_S0 = 128u * 127 * 64, CP_S1 = CP_S0 + 128u * 127 * 128, CP_S2 = CP_S1 + 128u * 511 * 128, CP_TOT = CP_S2 + 128u * 2047 * 128;
__device__ __forceinline__ void copy_slice(KParams P, unsigned lo, unsigned hi, unsigned t0, unsigned nthr) {
    if (lo < CP_S0 && hi > 0) copy_seg<128, 256>(P->in[2], P->out + O_AS, lo, hi < CP_S0 ? hi : CP_S0, t0, nthr);
    if (lo < CP_S1 && hi > CP_S0) copy_seg<128, 512>(P->in[3], P->out + O_B1S, (lo > CP_S0 ? lo : CP_S0) - CP_S0, (hi < CP_S1 ? hi : CP_S1) - CP_S0, t0, nthr);
    if (lo < CP_S2 && hi > CP_S1) copy_seg<512, 512>(P->in[4], P->out + O_B2S, (lo > CP_S1 ? lo : CP_S1) - CP_S1, (hi < CP_S2 ? hi : CP_S2) - CP_S1, t0, nthr);
    if (lo < CP_TOT && hi > CP_S2) copy_seg<2048, 512>(P->in[5], P->out + O_B3S, (lo > CP_S2 ? lo : CP_S2) - CP_S2, (hi < CP_TOT ? hi : CP_TOT) - CP_S2, t0, nthr);
}
constexpr unsigned cp_cut(double f) { return (unsigned)(f * (double)CP_TOT) & ~3u; }
constexpr unsigned CPC0 = 0, CPC1 = cp_cut(0.15), CPC2 = cp_cut(0.235), CPC3 = cp_cut(0.485), CPC4 = cp_cut(0.571), CPC5 = cp_cut(0.663), CPC6 = cp_cut(0.75), CPC7 = CP_TOT;
__device__ __forceinline__ void idle_copy(KParams P, int nwg, unsigned lo, unsigned hi, const int wave_sg) {
    const int G = gridDim.x, busy = nwg % G; const int tid = TID_NOW(wave_sg);
    if (busy == 0 || (int)blockIdx.x < busy) { if (busy == 0) copy_slice(P, lo, hi, blockIdx.x * 512 + tid, G * 512); return; }
    copy_slice(P, lo, hi, (blockIdx.x - busy) * 512 + tid, (G - busy) * 512);
}
__device__ __forceinline__ void phase_prologue(KParams P, LAS unsigned char* lds, const int wave_sg) {
    const int tid = TID_NOW(wave_sg), lane = tid & 63, wave = wave_sg;
    const int gw = blockIdx.x * 8 + wave, NGW = gridDim.x * 8;
    unsigned char* ws = P->ws;
    LAS float* scr = (LAS float*)(lds + wave * 16384);
    constexpr int I_GU = 16 * 176, I_D = 44 * 32, I_IN = 16 * 160, I_UA = 8 * 32, I_UB = 4 * 32, I_O = 16 * 32;
    constexpr int NITEMS = 2 * I_GU + 2 * I_D + I_IN + I_UA + I_UB + I_O;
    for (int it = gw; it < NITEMS; it += NGW) {
        int r = it;
        if (r < 2 * I_GU) { const int L = r / I_GU; r -= L * I_GU; const int kb = r / 176, nb = r % 176, nd0 = 32 * nb, pn = nd0 >> 8, bj = (nd0 >> 7) & 1, c = nd0 & 127;
            const float* W = P->in[L ? (bj ? 22 : 21) : (bj ? 8 : 7)];
            tr_item(W, DFF, 64 * kb, 128 * pn + c, (bf16*)(ws + (L ? WS_W2GU : WS_W1GU)), DM, nd0, P->in[L ? 20 : 6], scr, lane); continue; }
        r -= 2 * I_GU;
        if (r < 2 * I_D) { const int L = r / I_D; r -= L * I_D; const int kb = r / 32, nb = r % 32;
            tr_item(P->in[L ? 23 : 9], DM, 64 * kb, 32 * nb, (bf16*)(ws + (L ? WS_W2D : WS_W1D)), DFF, 32 * nb, nullptr, scr, lane); continue; }
        r -= 2 * I_D;
        if (r < I_IN) { const int kb = r / 160, nb = r % 160, nd0 = 32 * nb; int ns0 = nd0;
            if (nd0 < 3072) { const int pn = nd0 >> 8, cl = nd0 & 255, bj = cl >> 7, wc = (cl >> 5) & 3; ns0 = 64 * (4 * pn + wc) + 32 * bj; }
            tr_item(P->in[11], INW, 64 * kb, ns0, (bf16*)(ws + WS_WIN), DM, nd0, P->in[10], scr, lane); continue; }
        r -= I_IN;
        if (r < I_UA) { const int kb = r / 32, nb = r % 32; tr_item(P->in[17], DM, 64 * kb, 32 * nb, (bf16*)(ws + WS_WUA), 768, 32 * nb, nullptr, scr, lane); continue; }
        r -= I_UA;
        if (r < I_UB) { const int kb = r / 32, nb = r % 32; tr_item(P->in[18], DM, 64 * kb, 32 * nb, (bf16*)(ws + WS_WUA) + 512, 768, 32 * nb, nullptr, scr, lane); continue; }
        r -= I_UB;
        { const int kb = r / 32, nb = r % 32; tr_item(P->in[19], DM, 64 * kb, 32 * nb, (bf16*)(ws + WS_WO), DM, 32 * nb, nullptr, scr, lane); }
    }
    float* ss1 = (float*)(ws + WS_SS1); float* ss2 = (float*)(ws + WS_SS2); float* ss3 = (float*)(ws + WS_SS3);
    bf16* XB = (bf16*)(ws + WS_XB);
    for (int m = gw; m < MP; m += NGW) {
        unsigned long long* o8 = (unsigned long long*)(XB + (size_t)m * DM) + lane;
        if (m < MV) {
            const float* xr = (m < MPR) ? P->in[0] + (size_t)m * DM : P->in[1] + (size_t)(m - MPR) * DM;
            const f32x4* x4 = (const f32x4*)xr + lane; f32x4 v[4]; float s = 0.f;
#pragma unroll
            for (int j = 0; j < 4; ++j) { v[j] = x4[64 * j]; s += (v[j].x * v[j].x + v[j].y * v[j].y) + (v[j].z * v[j].z + v[j].w * v[j].w); }
            s = wave_sum(s);
#pragma unroll
            for (int j = 0; j < 4; ++j) o8[64 * j] = (unsigned long long)cvt_pk_bf16(v[j].x, v[j].y) | ((unsigned long long)cvt_pk_bf16(v[j].z, v[j].w) << 32);
            if (lane == 0) ss1[m] = s;
        } else {
#pragma unroll
            for (int j = 0; j < 4; ++j) o8[64 * j] = 0ull;
            if (lane == 0) ss1[m] = 0.f;
        }
    }
    const long gtid = (long)blockIdx.x * 512 + tid, gthreads = (long)gridDim.x * 512;
    for (long i = gtid; i < MP; i += gthreads) { ss2[i] = 0.f; ss3[i] = 0.f; }
    for (long i = gtid; i < (long)(3 * ACC_FLOATS + 3 * 64); i += gthreads) ((float*)(ws + WS_ACC))[i] = 0.f;
    if (blockIdx.x == 0 && tid < 320) { float* GT = (float*)(ws + WS_GT); const int r = tid >> 6, d = tid & 63;
        float v = 1.f; if (r == 0) v = P->in[12][d] * QSCALE; else if (r == 1) v = P->in[13][d]; else if (r == 2) v = P->in[14][d] * QSCALE; else if (r == 3) v = P->in[15][d];
        GT[tid] = v; }
    if (gridDim.x != 256) copy_slice(P, 0u, CP_TOT, (unsigned)gtid, (unsigned)gthreads);
}

struct EpiSwiGLU {
    static constexpr bool PERM = true, AFTER_DRAIN = false; static constexpr int HOOK_T = -1;
    bf16* H; const float* ss;
    __device__ __forceinline__ void operator()(const f32x4 (&acc)[2][2][4][2], const pg8::Unit& u, int wr, int wc, int fr, int fq) const {
        const int row0 = u.pm * 256 + wr * 64 + fr, col0 = u.pn * 128 + wc * 32 + 8 * fq;
#pragma unroll
        for (int ai = 0; ai < 2; ++ai)
#pragma unroll
            for (int m = 0; m < 4; ++m) { const int row = row0 + ai * 128 + m * 16; const float rs = __builtin_amdgcn_rsqf(ss[row] * (1.f / DM) + EPS);
                float h[8];
#pragma unroll
                for (int n = 0; n < 2; ++n)
#pragma unroll
                    for (int j = 0; j < 4; ++j) { const float g = acc[ai][0][m][n][j] * rs, up = acc[ai][1][m][n][j] * rs; h[4 * n + j] = g * sigmoidf_(g) * up; }
                u32x4 w; w.x = cvt_pk_bf16(h[0], h[1]); w.y = cvt_pk_bf16(h[2], h[3]); w.z = cvt_pk_bf16(h[4], h[5]); w.w = cvt_pk_bf16(h[6], h[7]);
                *(u32x4*)(H + (size_t)row * DFF + col0) = w; }
    }
};
template <bool RESB, bool OUTF> struct EpiRes {
    static constexpr bool PERM = false, AFTER_DRAIN = false; static constexpr int HOOK_T = -1;
    const float* res_p; const float* res_s; const bf16* resb; float* out; bf16* outb; float* ss; float scale;
    __device__ __forceinline__ void operator()(const f32x4 (&acc)[2][2][4][2], const pg8::Unit& u, int wr, int wc, int fr, int fq) const {
        const int row0 = u.pm * 256 + wr * 64 + fr, col0 = u.pn * 256 + wc * 32 + 4 * fq;
#pragma unroll
        for (int ai = 0; ai < 2; ++ai)
#pragma unroll
            for (int m = 0; m < 4; ++m) { const int row = row0 + ai * 128 + m * 16;
                if (row < MV) {
                    const float* rp = (row < MPR) ? res_p + (size_t)row * DM : res_s + (size_t)(row - MPR) * DM;
                    float s = 0.f;
#pragma unroll
                    for (int bj = 0; bj < 2; ++bj)
#pragma unroll
                        for (int n = 0; n < 2; ++n) { const int col = col0 + bj * 128 + n * 16; f32x4 r;
                            if (RESB) { const u32x2 rw = *(const u32x2*)(resb + (size_t)row * DM + col); r = (f32x4){bf2f(rw.x & 0xffff), bf2f(rw.x >> 16), bf2f(rw.y & 0xffff), bf2f(rw.y >> 16)}; }
                            else r = *(const f32x4*)(rp + col);
                            const f32x4 v = r + acc[ai][bj][m][n] * scale;
                            if (OUTF) *(f32x4*)(out + (size_t)row * DM + col) = v;
                            else { u32x2 w; w.x = cvt_pk_bf16(v[0], v[1]); w.y = cvt_pk_bf16(v[2], v[3]); *(u32x2*)(outb + (size_t)row * DM + col) = w;
                                s += (v[0] * v[0] + v[1] * v[1]) + (v[2] * v[2] + v[3] * v[3]); } }
                    if (!OUTF) { s += __shfl_xor(s, 16); s += __shfl_xor(s, 32); if (fq == 0) atomicAdd(ss + row, s); }
                }
            }
    }
};
struct EpiQKV {
    static constexpr bool PERM = false, AFTER_DRAIN = false; static constexpr int HOOK_T = -1;
    const float* ss; unsigned char* wsb; bf16* G; float* dout; const float* GT;
    __device__ __forceinline__ void operator()(const f32x4 (&acc)[2][2][4][2], const pg8::Unit& u, int wr, int wc, int fr, int fq) const {
        const int row0 = u.pm * 256 + wr * 64 + fr;
        if (u.pn >= 12) {
            const int col0 = (u.pn - 12) * 256 + wc * 32 + 4 * fq;
#pragma unroll
            for (int ai = 0; ai < 2; ++ai)
#pragma unroll
                for (int m = 0; m < 4; ++m) { const int row = row0 + ai * 128 + m * 16; const float rs = __builtin_amdgcn_rsqf(ss[row] * (1.f / DM) + EPS);
#pragma unroll
                    for (int bj = 0; bj < 2; ++bj)
#pragma unroll
                        for (int n = 0; n < 2; ++n) { const f32x4 a = acc[ai][bj][m][n] * rs; u32x2 w; w.x = cvt_pk_bf16(sigmoidf_(a[0]), sigmoidf_(a[1])); w.y = cvt_pk_bf16(sigmoidf_(a[2]), sigmoidf_(a[3]));
                            *(u32x2*)(G + (size_t)row * 2048 + col0 + bj * 128 + n * 16) = w; } }
            return;
        }
        const int hd = 4 * u.pn + wc;
        const bool isA = hd < 12; const int hb = isA ? 0 : hd - 12, t = hb / 12, jj = hb - 12 * t, g = isA ? 0 : (jj >> 2);
        const int kind = isA ? ((hd >= 8) + (hd >= 10)) : t;
        const int hs = isA ? (hd & 1) : (jj & 3), H = isA ? 2 : 4;
        const int idx = isA ? (kind == 0 ? hd : hs) : ((kind == 0 ? 8 : 2) + jj);
        const int sh = 2 * g, dil = 1 << sh, win = 128 << sh;
        const size_t so_p = isA ? O_AP : (O_B1P + (g > 0 ? O_B2P - O_B1P : 0) + (g > 1 ? O_B3P - O_B2P : 0));
        const size_t so_s = isA ? O_AS : (O_B1S + (g > 0 ? O_B2S - O_B1S : 0) + (g > 1 ? O_B3S - O_B2S : 0));
        const int gi = (kind == 2) ? 4 : ((isA ? 0 : 2) + kind);
        const size_t boff = WS_QP + (kind > 0 ? WS_KP - WS_QP : 0) + (kind > 1 ? WS_VP - WS_KP : 0); const int nh = kind == 0 ? 20 : 14;
        f32x4 gv[2][2];
#pragma unroll
        for (int bj = 0; bj < 2; ++bj)
#pragma unroll
            for (int n = 0; n < 2; ++n) gv[bj][n] = *(const f32x4*)(GT + gi * 64 + 32 * bj + 16 * n + 4 * fq);
#pragma unroll
        for (int ai = 0; ai < 2; ++ai)
#pragma unroll
            for (int m = 0; m < 4; ++m) { const int row = row0 + ai * 128 + m * 16; const float rs = __builtin_amdgcn_rsqf(ss[row] * (1.f / DM) + EPS);
                f32x4 v[2][2]; float s = 0.f;
#pragma unroll
                for (int bj = 0; bj < 2; ++bj)
#pragma unroll
                    for (int n = 0; n < 2; ++n) { v[bj][n] = acc[ai][bj][m][n] * rs; s += (v[bj][n][0] * v[bj][n][0] + v[bj][n][1] * v[bj][n][1]) + (v[bj][n][2] * v[bj][n][2] + v[bj][n][3] * v[bj][n][3]); }
                s += __shfl_xor(s, 16); s += __shfl_xor(s, 32);
                const float inv = (kind < 2) ? __builtin_amdgcn_rsqf(s * (1.f / 64.f) + EPS) : 1.f;
#pragma unroll
                for (int bj = 0; bj < 2; ++bj)
#pragma unroll
                    for (int n = 0; n < 2; ++n) v[bj][n] = v[bj][n] * gv[bj][n] * inv;
                if (row < MPR) {
                    const int b = row >> 11, sq = row & 2047, p = ((sq & (dil - 1)) << (11 - sh)) + (sq >> sh);
                    bf16* dst = (bf16*)(wsb + boff) + ((size_t)(b * nh + idx) * 2048 + p) * 64;
#pragma unroll
                    for (int bj = 0; bj < 2; ++bj)
#pragma unroll
                        for (int n = 0; n < 2; ++n) { u32x2 w; w.x = cvt_pk_bf16(v[bj][n][0], v[bj][n][1]); w.y = cvt_pk_bf16(v[bj][n][2], v[bj][n][3]); *(u32x2*)(dst + 32 * bj + 16 * n + 4 * fq) = w; }
                    if (kind > 0 && sq >= 2048 - win) {
                        float* sd = dout + so_p + ((((size_t)b * win + (sq - (2048 - win))) * 2 + (kind - 1)) * H + hs) * 64;
#pragma unroll
                        for (int bj = 0; bj < 2; ++bj)
#pragma unroll
                            for (int n = 0; n < 2; ++n) *(f32x4*)(sd + 32 * bj + 16 * n + 4 * fq) = v[bj][n];
                    }
                } else if (row < MV) {
                    const int nn = row - MPR;
                    if (kind == 0) { float* sd = (float*)(wsb + WS_QS) + ((size_t)nn * 20 + idx) * 64;
#pragma unroll
                        for (int bj = 0; bj < 2; ++bj)
#pragma unroll
                            for (int n = 0; n < 2; ++n) *(f32x4*)(sd + 32 * bj + 16 * n + 4 * fq) = v[bj][n];
                    } else { float* sd = dout + so_s + ((((size_t)nn * win + (win - 1)) * 2 + (kind - 1)) * H + hs) * 64;
#pragma unroll
                        for (int bj = 0; bj < 2; ++bj)
#pragma unroll
                            for (int n = 0; n < 2; ++n) *(f32x4*)(sd + 32 * bj + 16 * n + 4 * fq) = v[bj][n];
                    }
                }
            }
    }
};
struct EpiUp {
    static constexpr bool PERM = true, AFTER_DRAIN = false; static constexpr int HOOK_T = 8;
    const bf16* G; bf16* MIXB;
    __device__ __forceinline__ void hook(f32x4 (&acc)[2][2][4][2], const pg8::Unit& u, int wr, int wc, int fr_, int fq) const {
        int fr = fr_; asm volatile("" : "+v"(fr));
        const int row0 = u.pm * 256 + wr * 64 + fr, col0 = u.pn * 256 + wc * 32 + 8 * fq;
#pragma unroll
        for (int ai = 0; ai < 2; ++ai)
#pragma unroll
            for (int m = 0; m < 4; ++m) { const int row = row0 + ai * 128 + m * 16;
#pragma unroll
                for (int bj = 0; bj < 2; ++bj) { const int col = col0 + bj * 128;
                    const unsigned goff = (unsigned)(row * 2048 + col) * 2u;
                    const u32x4 ga = *(const u32x4*)((const char*)G + goff), gb = *(const u32x4*)((const char*)G + goff + 2048u);
#define RT(a, b) ((a) * __builtin_amdgcn_rcpf(fmaxf((b), 1e-20f)))
                    const f32x4 r0 = {RT(bf2f(ga.x & 0xffff), bf2f(gb.x & 0xffff)), RT(bf2f(ga.x >> 16), bf2f(gb.x >> 16)), RT(bf2f(ga.y & 0xffff), bf2f(gb.y & 0xffff)), RT(bf2f(ga.y >> 16), bf2f(gb.y >> 16))};
                    const f32x4 r1 = {RT(bf2f(ga.z & 0xffff), bf2f(gb.z & 0xffff)), RT(bf2f(ga.z >> 16), bf2f(gb.z >> 16)), RT(bf2f(ga.w & 0xffff), bf2f(gb.w & 0xffff)), RT(bf2f(ga.w >> 16), bf2f(gb.w >> 16))};
#undef RT
                    acc[ai][bj][m][0] = acc[ai][bj][m][0] * r0; acc[ai][bj][m][1] = acc[ai][bj][m][1] * r1;
                    asm volatile("" ::: "memory"); } }
    }
    __device__ __forceinline__ void operator()(const f32x4 (&acc)[2][2][4][2], const pg8::Unit& u, int wr, int wc, int fr, int fq) const {
        const int row0 = u.pm * 256 + wr * 64 + fr, col0 = u.pn * 256 + wc * 32 + 8 * fq;
#pragma unroll
        for (int ai = 0; ai < 2; ++ai)
#pragma unroll
            for (int m = 0; m < 4; ++m) { const int row = row0 + ai * 128 + m * 16;
#pragma unroll
                for (int bj = 0; bj < 2; ++bj) { const int col = col0 + bj * 128;
                    const u32x4 gb = *(const u32x4*)(G + (size_t)row * 2048 + 1024 + col);
                    const f32x4 g0 = {fmaxf(bf2f(gb.x & 0xffff), 1e-20f), fmaxf(bf2f(gb.x >> 16), 1e-20f), fmaxf(bf2f(gb.y & 0xffff), 1e-20f), fmaxf(bf2f(gb.y >> 16), 1e-20f)};
                    const f32x4 g1 = {fmaxf(bf2f(gb.z & 0xffff), 1e-20f), fmaxf(bf2f(gb.z >> 16), 1e-20f), fmaxf(bf2f(gb.w & 0xffff), 1e-20f), fmaxf(bf2f(gb.w >> 16), 1e-20f)};
                    const f32x4 v0 = acc[ai][bj][m][0] * g0, v1 = acc[ai][bj][m][1] * g1;
                    u32x4 w; w.x = cvt_pk_bf16(v0[0], v0[1]); w.y = cvt_pk_bf16(v0[2], v0[3]); w.z = cvt_pk_bf16(v1[0], v1[1]); w.w = cvt_pk_bf16(v1[2], v1[3]);
                    *(u32x4*)(MIXB + (size_t)row * DM + col) = w; } }
    }
};

__device__ __forceinline__ int crow_c(int r) { return (r & 3) + 8 * (r >> 2); }
__device__ __forceinline__ s16x4 vtr(const LAS unsigned char* p) { typedef short v4i16_t __attribute__((ext_vector_type(4))); return __builtin_bit_cast(s16x4, __builtin_amdgcn_ds_read_tr16_b64_v4i16((LAS v4i16_t*)p)); }

__device__ __forceinline__ void phase_attention(KParams P, LAS unsigned char* lds, const int wave_sg) {
    const int tid = TID_NOW(wave_sg), lane = tid & 63, wave = wave_sg;
    unsigned char* ws = P->ws;
    const bf16* QP = (const bf16*)(ws + WS_QP); const bf16* KP = (const bf16*)(ws + WS_KP); const bf16* VP = (const bf16*)(ws + WS_VP);
    const float* QS = (const float*)(ws + WS_QS);
    bf16* OA = (bf16*)(ws + WS_XAB); bf16* OB3 = (bf16*)(ws + WS_OB3); float* LSE3 = (float*)(ws + WS_LSE3);
    const float* sinks = P->in[16];
    {
        LAS float* pl = (LAS float*)(lds + ATT_PL) + wave * 192;
        for (int widx = blockIdx.x * 8 + wave; widx < NS * 20; widx += gridDim.x * 8) {
            const int n = widx / 20, hq = widx % 20;
            const float* cache; int H, L, dil, h; size_t so; int g = 0, slot = 0;
            if (hq < 8) { cache = P->in[2]; H = 2; L = 128; dil = 1; h = hq >> 2; so = O_AS; }
            else { const int jj = hq - 8; g = jj >> 2; slot = jj & 3; h = slot; H = 4; dil = 1 << (2 * g); L = 128 * dil; cache = (g > 1) ? P->in[5] : (g > 0 ? P->in[4] : P->in[3]); so = O_B1S + (g > 0 ? O_B2S - O_B1S : 0) + (g > 1 ? O_B3S - O_B2S : 0); }
            const float slope2 = exp2f(-0.4f * (float)(hq + 1)) * LOG2E * (float)dil;
            const float* newk = P->out + so + ((((size_t)n * L + (L - 1)) * 2 + 0) * H + h) * 64;
            const float* newv = newk + H * 64;
            const float* cb = cache + (size_t)n * L * 2 * H * 64;
            const f32x4* q4 = (const f32x4*)(QS + ((size_t)n * 20 + hq) * 64);
            float sv[3];
#pragma unroll
            for (int rd = 0; rd < 3; ++rd) {
                const int mm = lane + 64 * rd; const bool valid = mm <= 128; const int mc = valid ? mm : 0;
                const f32x4* k4 = (const f32x4*)((mc == 0) ? newk : cb + ((size_t)(L - dil * mc) * 2 * H + h) * 64);
                float dot = 0.f;
#pragma unroll
                for (int d = 0; d < 16; ++d) { const f32x4 a = q4[d], b = k4[d]; dot += (a[0] * b[0] + a[1] * b[1]) + (a[2] * b[2] + a[3] * b[3]); }
                sv[rd] = valid ? dot - slope2 * (float)mm : -1e30f;
            }
            float mx = wave_max(fmaxf(fmaxf(sv[0], sv[1]), sv[2]));
            float sink2 = 0.f;
            if (hq < 8) { sink2 = sinks[hq] * LOG2E; mx = fmaxf(mx, sink2); }
            float lsum = 0.f;
#pragma unroll
            for (int rd = 0; rd < 3; ++rd) { const float p = __builtin_amdgcn_exp2f(sv[rd] - mx); pl[lane + 64 * rd] = p; lsum += p; }
            lsum = wave_sum(lsum);
            if (hq < 8) lsum += __builtin_amdgcn_exp2f(sink2 - mx);
            asm volatile("s_waitcnt lgkmcnt(0)" ::: "memory");
            const int kg = lane >> 4, dq = lane & 15;
            f32x4 o4 = {0.f, 0.f, 0.f, 0.f};
#pragma unroll
            for (int i0 = 0; i0 < 33; i0 += 11) {
                f32x4 vv[11]; float pp[11];
#pragma unroll
                for (int i = 0; i < 11; ++i) { const int mm = 4 * (i0 + i) + kg; const int mc = mm <= 128 ? mm : 128;
                    const float* vp = (mc == 0) ? newv : cb + ((size_t)(L - dil * mc) * 2 * H + H + h) * 64;
                    vv[i] = *(const f32x4*)(vp + 4 * dq); pp[i] = pl[mm]; }
#pragma unroll
                for (int i = 0; i < 11; ++i) o4 = o4 + vv[i] * pp[i];
            }
#pragma unroll
            for (int c = 0; c < 4; ++c) { o4[c] += __shfl_xor(o4[c], 16); o4[c] += __shfl_xor(o4[c], 32); }
            const float il = __builtin_amdgcn_rcpf(lsum);
            const size_t row = MPR + n;
            u32x2 ow; ow.x = cvt_pk_bf16(o4[0] * il, o4[1] * il); ow.y = cvt_pk_bf16(o4[2] * il, o4[3] * il);
            if (hq < 8) { if (kg == 0) *(u32x2*)(OA + row * 768 + hq * 64 + 4 * dq) = ow; }
            else { if (kg == 0) *(u32x2*)(OB3 + ((size_t)g * MP + row) * 256 + slot * 64 + 4 * dq) = ow; if (lane == 0) LSE3[((size_t)g * MP + row) * 4 + slot] = (mx + __builtin_amdgcn_logf(lsum)) * LN2; }
            asm volatile("s_waitcnt lgkmcnt(0)" ::: "memory");
        }
    }
    const int half = wave >> 2, w = wave & 3, r32 = lane & 31, hi = lane >> 5, htid = tid & 255;
    LAS unsigned char* Kl = lds + half * ATT_HALF; LAS unsigned char* Vl = Kl + 256 * ATT_KROW;
    u32x4 kreg[8], vreg[8]; bf16x8 qn[4];
#define ATT_DECODE(pair_) const int it = 2 * (pair_) + half, b = it / 320, rem = it - 320 * b, hq = rem >> 4, j = rem & 15; \
        const int jj = hq - 8, g = hq < 8 ? 0 : (jj >> 2), slot = jj & 3, kidx = hq < 8 ? (hq >> 2) : 2 + jj, dil = 1 << (2 * g)
#define ATT_LOAD(pair_) do { ATT_DECODE(pair_); const int krow0 = 128 * j - 128; \
        const bf16* Kg = KP + ((size_t)(b * 14 + kidx) * 2048) * 64; const bf16* Vg = VP + ((size_t)(b * 14 + kidx) * 2048) * 64; \
        const bf16* Qg = QP + ((size_t)(b * 20 + hq) * 2048 + 128 * j + 32 * w + r32) * 64 + hi * 8; \
        _Pragma("unroll") for (int d0 = 0; d0 < 4; ++d0) qn[d0] = *(const bf16x8*)(Qg + d0 * 16); \
        _Pragma("unroll") for (int c = 0; c < 8; ++c) { const int ch = htid + 256 * c; int grow = krow0 + (ch >> 3); grow = grow < 0 ? grow + 128 : grow; const size_t off = (size_t)grow * 64 + (ch & 7) * 8; \
            kreg[c] = *(const u32x4*)(Kg + off); vreg[c] = *(const u32x4*)(Vg + off); } } while (0)
    if ((int)blockIdx.x < 2560) ATT_LOAD((int)blockIdx.x);
    for (int pair = blockIdx.x; pair < 2560; pair += gridDim.x) {
        ATT_DECODE(pair);
        const int nblk = 16 >> (2 * g), blk = j & (nblk - 1), rres = j >> (4 - 2 * g); const bool hasprev = blk != 0;
        const float sd = exp2f(-0.4f * (float)(hq + 1)) * LOG2E * (float)dil;
        __syncthreads();
#pragma unroll
        for (int c = 0; c < 8; ++c) { const int ch = htid + 256 * c, row = ch >> 3, cc = ch & 7; *(LAS u32x4*)(Kl + row * ATT_KROW + cc * 16) = kreg[c]; *(LAS u32x4*)(Vl + row * ATT_KROW + cc * 16) = vreg[c]; }
        bf16x8 qf[4];
#pragma unroll
        for (int d0 = 0; d0 < 4; ++d0) qf[d0] = qn[d0];
        __syncthreads();
        if (pair + (int)gridDim.x < 2560) ATT_LOAD(pair + (int)gridDim.x);
        float sink2 = 0.f, mx = -1e30f, lsum = 0.f;
        if (hq < 8) { sink2 = sinks[hq] * LOG2E; mx = sink2; lsum = hi == 0 ? 1.f : 0.f; }
        f32x16 o[2];
        o[0] = (f32x16){0.f, 0.f, 0.f, 0.f, 0.f, 0.f, 0.f, 0.f, 0.f, 0.f, 0.f, 0.f, 0.f, 0.f, 0.f, 0.f}; o[1] = o[0];
        const LAS unsigned char* vb = Vl + (32 * w + 4 * hi + ((lane & 15) >> 2)) * ATT_KROW + (16 * ((lane >> 4) & 1) + 4 * (lane & 3)) * 2;
#pragma unroll
        for (int kbi = 0; kbi < 5; ++kbi) { const int kb = 4 - kbi;
            f32x16 S = (f32x16){0.f, 0.f, 0.f, 0.f, 0.f, 0.f, 0.f, 0.f, 0.f, 0.f, 0.f, 0.f, 0.f, 0.f, 0.f, 0.f};
            const LAS unsigned char* kp = Kl + (32 * w + 32 * kb + r32) * ATT_KROW + hi * 16;
#pragma unroll
            for (int d0 = 0; d0 < 4; ++d0) { const bf16x8 kf = *(const LAS bf16x8*)(kp + d0 * 32); S = __builtin_amdgcn_mfma_f32_32x32x16_bf16(kf, qf[d0], S, 0, 0, 0); }
            float tmax = -1e30f;
#pragma unroll
            for (int r = 0; r < 16; ++r) { const int c = crow_c(r) + 4 * hi; const int dist = r32 + 128 - 32 * kb - c;
                float v = S[r] - sd * (float)dist;
                if (kb == 0) v = dist <= 128 ? v : -1e30f;
                if (kb == 4) v = dist >= 0 ? v : -1e30f;
                if (kb < 4) { const int ki = 32 * w + 32 * kb + c; v = (hasprev || ki >= 128) ? v : -1e30f; }
                S[r] = v; tmax = fmaxf(tmax, v); }
            tmax = fmaxf(tmax, __shfl_xor(tmax, 32));
            const float mnew = fmaxf(mx, tmax);
            if (kbi > 0 && __builtin_amdgcn_ballot_w64(mnew > mx) != 0ull) { const float al = __builtin_amdgcn_exp2f(mx - mnew); lsum *= al;
#pragma unroll
                for (int r = 0; r < 16; ++r) { o[0][r] *= al; o[1][r] *= al; } }
            else if (kbi == 0) lsum *= __builtin_amdgcn_exp2f(mx - mnew);
            mx = mnew;
#pragma unroll
            for (int r = 0; r < 16; ++r) { const float p = __builtin_amdgcn_exp2f(S[r] - mx); S[r] = p; lsum += p; }
#pragma unroll
            for (int kk = 0; kk < 2; ++kk) {
                u32x4 pw; pw.x = cvt_pk_bf16(S[8 * kk + 0], S[8 * kk + 1]); pw.y = cvt_pk_bf16(S[8 * kk + 2], S[8 * kk + 3]); pw.z = cvt_pk_bf16(S[8 * kk + 4], S[8 * kk + 5]); pw.w = cvt_pk_bf16(S[8 * kk + 6], S[8 * kk + 7]);
                const bf16x8 pf = __builtin_bit_cast(bf16x8, pw);
#pragma unroll
                for (int dh = 0; dh < 2; ++dh) {
                    const LAS unsigned char* vp = vb + (32 * kb + 16 * kk) * ATT_KROW + dh * 64;
                    const s16x4 lo = vtr(vp), hh = vtr(vp + 8 * ATT_KROW);
                    const bf16x8 vf = {lo[0], lo[1], lo[2], lo[3], hh[0], hh[1], hh[2], hh[3]};
                    o[dh] = __builtin_amdgcn_mfma_f32_32x32x16_bf16(vf, pf, o[dh], 0, 0, 0);
                }
            }
        }
        lsum += __shfl_xor(lsum, 32);
        const float inv = __builtin_amdgcn_rcpf(lsum);
        const int sq = (blk * 128 + 32 * w + r32) * dil + rres; const size_t row = (size_t)b * 2048 + sq;
        bf16* dst = (hq < 8) ? OA + row * 768 + hq * 64 : OB3 + ((size_t)g * MP + row) * 256 + slot * 64;
#pragma unroll
        for (int dh = 0; dh < 2; ++dh)
#pragma unroll
            for (int c = 0; c < 4; ++c) { u32x2 wv; wv.x = cvt_pk_bf16(o[dh][4 * c] * inv, o[dh][4 * c + 1] * inv); wv.y = cvt_pk_bf16(o[dh][4 * c + 2] * inv, o[dh][4 * c + 3] * inv);
                *(u32x2*)(dst + 32 * dh + 8 * c + 4 * hi) = wv; }
        if (hq >= 8 && hi == 0) LSE3[((size_t)g * MP + row) * 4 + slot] = (mx + __builtin_amdgcn_logf(lsum)) * LN2;
    }
#undef ATT_LOAD
#undef ATT_DECODE
    __syncthreads();
}

__device__ __forceinline__ void phase_merge(KParams P, const int wave_sg) {
    unsigned char* ws = P->ws;
    const bf16* OB3 = (const bf16*)(ws + WS_OB3); const float* LSE3 = (const float*)(ws + WS_LSE3); bf16* OBM = (bf16*)(ws + WS_XAB) + 512;
    const long gtid = (long)blockIdx.x * 512 + TID_NOW(wave_sg), gthreads = (long)gridDim.x * 512;
    for (long i = gtid; i < (long)MV * 32; i += gthreads) {
        const long row = i >> 5; const int ch = (int)(i & 31), slot = ch >> 3;
        float l[3], mx = -1e30f;
#pragma unroll
        for (int g = 0; g < 3; ++g) { l[g] = LSE3[((size_t)g * MP + row) * 4 + slot]; mx = fmaxf(mx, l[g]); }
        float wsum = 0.f;
#pragma unroll
        for (int g = 0; g < 3; ++g) { l[g] = __builtin_amdgcn_exp2f((l[g] - mx) * LOG2E); wsum += l[g]; }
        const float inv = __builtin_amdgcn_rcpf(wsum);
        float a[8] = {0.f, 0.f, 0.f, 0.f, 0.f, 0.f, 0.f, 0.f};
#pragma unroll
        for (int g = 0; g < 3; ++g) { const u32x4 v = *(const u32x4*)(OB3 + ((size_t)g * MP + row) * 256 + ch * 8); const float wg = l[g] * inv;
            a[0] += wg * bf2f(v.x & 0xffff); a[1] += wg * bf2f(v.x >> 16); a[2] += wg * bf2f(v.y & 0xffff); a[3] += wg * bf2f(v.y >> 16);
            a[4] += wg * bf2f(v.z & 0xffff); a[5] += wg * bf2f(v.z >> 16); a[6] += wg * bf2f(v.w & 0xffff); a[7] += wg * bf2f(v.w >> 16); }
        u32x4 o; o.x = cvt_pk_bf16(a[0], a[1]); o.y = cvt_pk_bf16(a[2], a[3]); o.z = cvt_pk_bf16(a[4], a[5]); o.w = cvt_pk_bf16(a[6], a[7]);
        *(u32x4*)(OBM + row * 768 + ch * 8) = o;
    }
}

#define GEMM_PHASE(EPI, A_, B_, N_, K_, E_) do { pg8::Gemm g_{(const bf16*)(A_), (const bf16*)(B_), MP, (N_), (K_)}; pg8::SplitOrder S_; S_.init((N_), (K_), (int)gridDim.x, (int)blockIdx.x, 1, nullptr, nullptr); \
    pg8::gemm_phase<std::remove_reference_t<decltype(E_)>, pg8::SplitOrder, true, true>(lds, g_, S_, E_, wave_sg); } while (0)
#define GEMM_PHASE_BG(EPI, A_, B_, N_, K_, E_, BG_, SPLIT_, ACCI_) do { pg8::Gemm g_{(const bf16*)(A_), (const bf16*)(B_), MP, (N_), (K_)}; pg8::SplitOrder S_; \
    S_.init((N_), (K_), (int)gridDim.x, (int)blockIdx.x, (SPLIT_), (float*)(ws + WS_ACC) + (size_t)(ACCI_) * ACC_FLOATS, (unsigned*)(ws + WS_ACC + 3 * ACC_FLOATS * 4) + 64 * (ACCI_)); \
    pg8::gemm_phase<std::remove_reference_t<decltype(E_)>, pg8::SplitOrder, true, true, std::remove_reference_t<decltype(BG_)>>(lds, g_, S_, E_, wave_sg, BG_); } while (0)
typedef pg8::BgCopy<2047u * 128u, 2048u * 128u, 128u> BgB3;
typedef pg8::BgCopy<511u * 128u, 512u * 128u, 128u> BgB2;
constexpr unsigned BG_IT = 256u * 512u;
constexpr unsigned B3_TOT = 128u * 2047u * 128u, B2_TOT = 128u * 511u * 128u;
constexpr unsigned B3_C1 = 88u * BG_IT, B3_C2 = B3_C1 + 44u * BG_IT, B3_C3 = B3_C2 + 80u * BG_IT;
constexpr unsigned B2_C1 = 44u * BG_IT;
static_assert(B3_TOT - B3_C3 <= 88u * BG_IT && B2_C1 < B2_TOT, "background copy capacity");

#define LOADP(P_) KParams P_ = kp0; asm volatile("" : "+s"(P_)); unsigned char* const ws = P_->ws; (void)ws
__global__ void __launch_bounds__(512, 2) mega_fwd(Params Parg) {
    extern __shared__ __attribute__((aligned(16))) unsigned char lds_raw[];
    LAS unsigned char* lds = (LAS unsigned char*)lds_raw;
    cg::grid_group grid = cg::this_grid();
    const KParams kp0 = (KParams)__builtin_amdgcn_kernarg_segment_ptr();
    const int wave_sg = __builtin_amdgcn_readfirstlane(threadIdx.x >> 6);
    { LOADP(P); phase_prologue(P, lds, wave_sg); }
    grid.sync();
    const int bgr = (gridDim.x == 256) ? 1 : 0;
    { LOADP(P); { EpiSwiGLU E{(bf16*)(ws + WS_H), (const float*)(ws + WS_SS1)}; BgB3 bg{(const f32x4*)P->in[5], (f32x4*)(P->out + O_B3S), (f32x4*)(ws + WS_DUMP), 0u, B3_C1, 11 * bgr};
        GEMM_PHASE_BG(EpiSwiGLU, ws + WS_XB, ws + WS_W1GU, 2 * DFF, DM, E, bg, 1, 0); }
      if (bgr) { idle_copy(P, 129 * 22, 0u, CP_S1, wave_sg); idle_copy(P, 129 * 22, CP_S1 + B2_C1, CP_S2, wave_sg); } }
    grid.sync();
    { LOADP(P); { EpiRes<false, false> E{P->in[0], P->in[1], nullptr, nullptr, (bf16*)(ws + WS_X1B), (float*)(ws + WS_SS2), 0.5f}; BgB3 bg{(const f32x4*)P->in[5], (f32x4*)(P->out + O_B3S), (f32x4*)(ws + WS_DUMP), B3_C1, B3_C2, 2 * bgr};
        GEMM_PHASE_BG(0, ws + WS_H, ws + WS_W1D, DM, DFF, E, bg, 11, 0); } }
    grid.sync();
    { LOADP(P); { EpiQKV E{(const float*)(ws + WS_SS2), ws, (bf16*)(ws + WS_G), P->out, (const float*)(ws + WS_GT)}; BgB3 bg{(const f32x4*)P->in[5], (f32x4*)(P->out + O_B3S), (f32x4*)(ws + WS_DUMP), B3_C2, B3_C3, 10 * bgr};
        GEMM_PHASE_BG(EpiQKV, ws + WS_X1B, ws + WS_WIN, INW, DM, E, bg, 1, 0); } }
    grid.sync();
    { LOADP(P); phase_attention(P, lds, wave_sg); }
    grid.sync();
    { LOADP(P); phase_merge(P, wave_sg); }
    grid.sync();
    { LOADP(P); EpiUp E{(const bf16*)(ws + WS_G), (bf16*)(ws + WS_MIXB)}; GEMM_PHASE(EpiUp, ws + WS_XAB, ws + WS_WUA, DM, 768, E); }
    grid.sync();
    { LOADP(P); { EpiRes<true, false> E{nullptr, nullptr, (const bf16*)(ws + WS_X1B), nullptr, (bf16*)(ws + WS_X2B), (float*)(ws + WS_SS3), 1.0f}; pg8::BgNone bg; GEMM_PHASE_BG(0, ws + WS_MIXB, ws + WS_WO, DM, DM, E, bg, 4, 2); } }
    grid.sync();
    { LOADP(P); { EpiSwiGLU E{(bf16*)(ws + WS_H), (const float*)(ws + WS_SS3)}; BgB3 bg{(const f32x4*)P->in[5], (f32x4*)(P->out + O_B3S), (f32x4*)(ws + WS_DUMP), B3_C3, B3_TOT, 11 * bgr};
        GEMM_PHASE_BG(EpiSwiGLU, ws + WS_X2B, ws + WS_W2GU, 2 * DFF, DM, E, bg, 1, 0); } }
    grid.sync();
    { LOADP(P); { EpiRes<true, true> E{nullptr, nullptr, (const bf16*)(ws + WS_X2B), P->out, nullptr, nullptr, 0.5f}; BgB2 bg{(const f32x4*)P->in[4], (f32x4*)(P->out + O_B2S), (f32x4*)(ws + WS_DUMP), 0u, B2_C1, 2 * bgr};
        GEMM_PHASE_BG(0, ws + WS_H, ws + WS_W2D, DM, DFF, E, bg, 11, 1); } }
}

extern "C" void kernel_launch(void* const* d_in, const int* in_sizes, int n_in, void* d_out, int out_size, void* d_ws, size_t ws_size, hipStream_t stream) {
    static int grid = 0;
    if (grid == 0) {
        if (n_in != 24 || ws_size < WS_END) { fprintf(stderr, "kernel_launch: unexpected n_in %d / ws_size %zu\n", n_in, ws_size); grid = -1; return; }
        int dev = 0, cus = 0, per_cu = 0;
        hipGetDevice(&dev); hipDeviceGetAttribute(&cus, hipDeviceAttributeMultiprocessorCount, dev);
        if (hipFuncSetAttribute((const void*)mega_fwd, hipFuncAttributeMaxDynamicSharedMemorySize, LDS_BYTES) != hipSuccess) { fprintf(stderr, "kernel_launch: hipFuncSetAttribute failed\n"); grid = -1; return; }
        if (hipOccupancyMaxActiveBlocksPerMultiprocessor(&per_cu, (const void*)mega_fwd, 512, LDS_BYTES) != hipSuccess || per_cu < 1) { fprintf(stderr, "kernel_launch: occupancy query says %d\n", per_cu); per_cu = 1; }
        (void)hipGetLastError();
        grid = cus * per_cu;
        fprintf(stderr, "kernel_launch: grid %d (cus %d x %d)\n", grid, cus, per_cu);
    }
    if (grid < 0) return;
    Params p{};
    for (int i = 0; i < 24; ++i) p.in[i] = (const float*)d_in[i];
    p.out = (float*)d_out; p.ws = (unsigned char*)d_ws;
    void* args[] = {&p};
    hipError_t e = hipLaunchCooperativeKernel((const void*)mega_fwd, dim3(grid), dim3(512), args, LDS_BYTES, stream);
    if (e != hipSuccess) fprintf(stderr, "cooperative launch failed: %s (grid %d)\n", hipGetErrorString(e), grid);
}
```

```cpp
#include <hip/hip_runtime.h>
#include <hip/hip_cooperative_groups.h>
#include <cstdio>
#include <cstdint>
#include <type_traits>
namespace cg = cooperative_groups;
namespace pg8 {
#define PG8_LAS __attribute__((address_space(3)))
typedef unsigned short bf16_t;
typedef short bf16x8 __attribute__((ext_vector_type(8)));
typedef float f32x4 __attribute__((ext_vector_type(4)));
typedef unsigned u32x4 __attribute__((ext_vector_type(4)));
constexpr int BM = 256, BK = 64, HALF = 128, HTB = HALF * BK * 2  , STAGE_BYTES = 8 * HTB, NXCD = 8, WGM = 8;

__host__ __device__ __forceinline__ int lds_byte(int r, int c) { const int st = (r >> 4) * 2 + (c >> 5), rr = r & 15, cc = c & 31, ob = rr * 64 + cc * 2; return st * 1024 + (ob ^ (((ob >> 9) & 1) << 5)); }
__host__ __device__ __forceinline__ void stage_rc(int b, int& R, int& C) { const int st = b / 1024, sb = b % 1024, swz = sb ^ (((sb >> 9) & 1) << 5); R = (st >> 1) * 16 + swz / 64; C = (st & 1) * 32 + (swz % 64) / 2; }
__host__ __device__ __forceinline__ int perm32(int rho) { const int n = rho >> 4, i = rho & 15; return 8 * (i >> 2) + 4 * n + (i & 3); }

struct Unit { int pm, pn, kt0, nt, split; };
struct Gemm { const bf16_t* A; const bf16_t* Bt; int M, N, K; };

struct StaticOrder {
    int nM, nN, nwg, G, c;
    __host__ __device__ void init(int M, int N, int G_, int c_) { nM = M / BM; nN = N / BM; nwg = nM * nN; G = G_; c = c_; }
    __host__ __device__ bool next(int i, Unit& u) const {
        const long L = (long)i * G + c; if (L >= nwg) return false;
        int wgid = (int)L; { const int q = nwg / NXCD, r = nwg % NXCD, xcd = wgid % NXCD, off = wgid / NXCD; wgid = (xcd < r ? xcd * (q + 1) : r * (q + 1) + (xcd - r) * q) + off; }
        const int nig = WGM * nN, gid = wgid / nig, fm = gid * WGM, gsz = (nM - fm) < WGM ? (nM - fm) : WGM;
        u.pm = fm + ((wgid % nig) % gsz); u.pn = (wgid % nig) / gsz; u.kt0 = 0; u.nt = ntK; u.split = 1; return true;
    }
    __device__ __forceinline__ void a_ready(const Unit&) const {}
    __device__ __forceinline__ void done(const Unit&) const {}
    int ntK; float* acc_buf; unsigned* cnt;
};
struct SplitOrder {
    StaticOrder so; int nmain, ntot, S, ntK; float* acc_buf; unsigned* cnt;
    __host__ __device__ void init(int N, int K, int G_, int c_, int S_, float* ab, unsigned* cn) { so.init(128 * BM, N, G_, c_); so.ntK = K / BK; nmain = so.nwg; S = S_; ntK = K / BK; ntot = nmain + so.nN * S; acc_buf = ab; cnt = cn; }
    __host__ __device__ __forceinline__ bool next(int i, Unit& u) const {
        const long L = (long)i * so.G + so.c; if (L >= ntot) return false;
        int pm, pn, kt0 = 0, n = ntK, sp = 1;
        if (L < nmain) {
            int wgid = (int)L; { const int nwg = nmain, q = nwg / NXCD, r = nwg % NXCD, xcd = wgid % NXCD, off = wgid / NXCD; wgid = (xcd < r ? xcd * (q + 1) : r * (q + 1) + (xcd - r) * q) + off; }
            const int nig = WGM * so.nN, gid = wgid / nig, fm = gid * WGM, gsz = (128 - fm) < WGM ? (128 - fm) : WGM;
            pm = fm + ((wgid % nig) % gsz); pn = (wgid % nig) / gsz;
        } else { const int e = (int)L - nmain; pm = 128; pn = e / S; n = ntK / S; kt0 = (e - pn * S) * n; sp = S; }
        u.pm = pm; u.pn = pn; u.kt0 = kt0; u.nt = n; u.split = sp; return true;
    }
    __device__ __forceinline__ void a_ready(const Unit&) const {}
    __device__ __forceinline__ void done(const Unit&) const {}
};

__device__ __forceinline__ unsigned cvt_pk_bf16(float lo, float hi) { unsigned r; asm volatile("v_cvt_pk_bf16_f32 %0, %1, %2" : "=v"(r) : "v"(lo), "v"(hi)); return r; }
typedef float f32x2 __attribute__((ext_vector_type(2)));
struct BgNone { static constexpr unsigned PER = 0; };
template <unsigned PER_, unsigned LR4_, unsigned R4_> struct BgCopy { static constexpr unsigned PER = PER_, LR4 = LR4_, R4 = R4_; const f32x4* src; f32x4* dst; f32x4* dump; unsigned lo, hi; int rounds; };
template <class Epi, class Sched, bool ALIGN_EPI = false, bool SP2 = false, class Bg = BgNone>
__device__ __forceinline__ void gemm_phase(PG8_LAS unsigned char* lds, const Gemm g, const Sched& S, const Epi& E, const int wave_sg, const Bg& bg = Bg()) {
    int tid_; asm volatile("v_mbcnt_lo_u32_b32 %0, -1, 0\n\tv_mbcnt_hi_u32_b32 %0, -1, %0\n\tv_lshl_or_b32 %0, %1, 6, %0" : "=&v"(tid_) : "s"(wave_sg));
    const int tid = tid_, wid = __builtin_amdgcn_readfirstlane(tid >> 6), lane = tid & 63, wr = wid >> 2, wc = wid & 3, fr = lane & 15, fq = lane >> 4;
    const int K = g.K, nt = K / BK;
    unsigned voffA[2], voffB[2];
#pragma unroll
    for (int i = 0; i < 2; ++i) { int R, C; stage_rc(tid * 16 + i * 8192, R, C); const int Rb = Epi::PERM ? ((R & ~31) + perm32(R & 31)) : R;
        voffA[i] = (unsigned)(R * K + C) * 2u; voffB[i] = (unsigned)(Rb * K + C) * 2u; }
    const size_t kstep = (size_t)(BK * 2);
    const size_t hstep = (size_t)HALF * K * 2;
    const size_t tstep = 2 * hstep;
    const unsigned ldsw = (unsigned)wid * 1024u;
    const int aoff = lds_byte(wr * 64 + fr, fq * 8), boff = lds_byte(wc * 32 + fr, fq * 8);
#define PG8_SA(b, h) (((b) * 2 + (h)) * HTB)
#define PG8_SB(b, h) ((4 + (b) * 2 + (h)) * HTB)
#define PG8_STAGE(bufoff, gbase, voff) do { _Pragma("unroll") for (int _i = 0; _i < 2; ++_i) \
        __builtin_amdgcn_global_load_lds((const unsigned*)((const char*)(gbase) + (voff)[_i]), (PG8_LAS unsigned*)(lds + (bufoff) + ldsw + _i * 8192), 16, 0, 0); } while (0)
#define PG8_LDA(dst, b, h) do { _Pragma("unroll") for (int m = 0; m < 4; ++m) _Pragma("unroll") for (int k = 0; k < 2; ++k) dst[m][k] = *(const PG8_LAS bf16x8*)(lds + PG8_SA(b, h) + aoff + m * 2048 + k * 1024); } while (0)
#define PG8_LDB(dst, b, h) do { _Pragma("unroll") for (int n = 0; n < 2; ++n) _Pragma("unroll") for (int k = 0; k < 2; ++k) dst[n][k] = *(const PG8_LAS bf16x8*)(lds + PG8_SB(b, h) + boff + n * 2048 + k * 1024); } while (0)
#define PG8_MMA(ai, bj, At, Bt) do { __builtin_amdgcn_s_setprio(1); _Pragma("unroll") for (int m = 0; m < 4; ++m) _Pragma("unroll") for (int n = 0; n < 2; ++n) _Pragma("unroll") for (int k = 0; k < 2; ++k) \
        acc[ai][bj][m][n] = __builtin_amdgcn_mfma_f32_16x16x32_bf16(Bt[n][k], At[m][k], acc[ai][bj][m][n], 0, 0, 0); __builtin_amdgcn_s_setprio(0); } while (0)
#define PG8_WAIT_V(n) asm volatile("s_waitcnt vmcnt(" #n ")" ::: "memory")
#define PG8_WAIT_L(n) asm volatile("s_waitcnt lgkmcnt(" #n ")" ::: "memory")
#define PG8_BAR __builtin_amdgcn_s_barrier()
#define PG8_SCHED __builtin_amdgcn_sched_barrier(0)
    Unit cur, nxt; int ui = 0;
    f32x4 bgdata = {0.f, 0.f, 0.f, 0.f}; f32x4* bgdst = nullptr;
    if constexpr (Bg::PER != 0) bgdst = bg.dump + (size_t)blockIdx.x * 512 + tid;
    if (!S.next(0, cur)) return;
    f32x4 acc[2][2][4][2];
#pragma unroll
    for (int a = 0; a < 2; ++a)
#pragma unroll
        for (int b = 0; b < 2; ++b)
#pragma unroll
            for (int m = 0; m < 4; ++m)
#pragma unroll
                for (int n = 0; n < 2; ++n) acc[a][b][m][n] = (f32x4){0.f, 0.f, 0.f, 0.f};
    bf16x8 At[4][2], B0[2][2], B1[2][2];
    const char* cA = (const char*)g.A + (size_t)cur.pm * tstep + (size_t)cur.kt0 * kstep; const char* cB = (const char*)g.Bt + (size_t)cur.pn * tstep + (size_t)cur.kt0 * kstep;
    S.a_ready(cur);
    if constexpr (SP2) {
        PG8_STAGE(PG8_SB(0, 0), cB, voffB); PG8_STAGE(PG8_SB(0, 1), cB + hstep, voffB); PG8_STAGE(PG8_SA(0, 0), cA, voffA); PG8_STAGE(PG8_SA(0, 1), cA + hstep, voffA);
        if (wr == 1) PG8_BAR;
        PG8_WAIT_V(2); PG8_BAR;
        PG8_STAGE(PG8_SB(1, 0), cB + kstep, voffB); PG8_STAGE(PG8_SA(1, 0), cA + kstep, voffA); PG8_STAGE(PG8_SB(1, 1), cB + hstep + kstep, voffB);
        PG8_WAIT_V(6); PG8_BAR;
    } else {
        PG8_STAGE(PG8_SB(0, 0), cB, voffB); PG8_STAGE(PG8_SA(0, 0), cA, voffA); PG8_STAGE(PG8_SB(0, 1), cB + hstep, voffB); PG8_STAGE(PG8_SA(0, 1), cA + hstep, voffA);
        if (wr == 1) PG8_BAR;
        PG8_WAIT_V(4); PG8_BAR;
        PG8_STAGE(PG8_SB(1, 0), cB + kstep, voffB); PG8_STAGE(PG8_SA(1, 0), cA + kstep, voffA); PG8_STAGE(PG8_SB(1, 1), cB + hstep + kstep, voffB);
        PG8_WAIT_V(6); PG8_BAR;
    }
    for (;;) {
        const bool has_next = S.next(ui + 1, nxt);
        const char* nA = has_next ? (const char*)g.A + (size_t)nxt.pm * tstep + (size_t)nxt.kt0 * kstep : cA; const char* nB = has_next ? (const char*)g.Bt + (size_t)nxt.pn * tstep + (size_t)nxt.kt0 * kstep : cB;
        const int cnt_ = cur.nt;
        for (int t = 0; t < cnt_; t += 2) {
            if constexpr (Epi::HOOK_T >= 0) { if (t == Epi::HOOK_T) E.hook(acc, cur, wr, wc, fr, fq); }
            const bool last = (t == cnt_ - 2);
            const char* a1 = cA + (size_t)(t + 1) * kstep;
            const char* a2 = last ? nA : cA + (size_t)(t + 2) * kstep; const char* b2 = last ? nB : cB + (size_t)(t + 2) * kstep;
            const char* a3 = a2 + kstep; const char* b3 = b2 + kstep;
            if (last && has_next) S.a_ready(nxt);
            if constexpr (SP2) {
            bool bg_on = false;
            if constexpr (Bg::PER != 0) { bg_on = ui < bg.rounds;
                if (bg_on) {
                    const unsigned idx = bg.lo + (unsigned)((ui * (nt >> 1) + (t >> 1)) * (int)gridDim.x + (int)blockIdx.x) * 512u + (unsigned)tid; const bool ok = idx < bg.hi;
                    const unsigned n = idx / Bg::PER, j = idx - n * Bg::PER; const size_t so = (size_t)n * Bg::LR4 + j;
                    const f32x4* sp = ok ? bg.src + so + Bg::R4 : bg.src; f32x4* nd = ok ? bg.dst + so : bg.dump + (size_t)blockIdx.x * 512 + tid;
                    asm volatile("global_store_dwordx4 %1, %0, off nt\n\tglobal_load_dwordx4 %0, %2, off nt" : "+v"(bgdata) : "v"(bgdst), "v"(sp) : "memory");
                    bgdst = nd; } }
            PG8_LDB(B0, 0, 0); PG8_LDB(B1, 0, 1); PG8_SCHED; PG8_LDA(At, 0, 0); PG8_STAGE(PG8_SA(1, 1), a1 + hstep, voffA);
            if (bg_on) { PG8_WAIT_V(10); } else { PG8_WAIT_V(8); } PG8_WAIT_L(0); PG8_BAR; PG8_MMA(0, 0, At, B0); PG8_MMA(0, 1, At, B1); PG8_BAR; PG8_SCHED;
            PG8_LDA(At, 0, 1); PG8_STAGE(PG8_SB(0, 0), b2, voffB); PG8_STAGE(PG8_SB(0, 1), b2 + hstep, voffB); PG8_STAGE(PG8_SA(0, 0), a2, voffA);
            if (bg_on) { PG8_WAIT_V(10); } else { PG8_WAIT_V(8); } PG8_WAIT_L(0); PG8_BAR; PG8_MMA(1, 0, At, B0); PG8_MMA(1, 1, At, B1); PG8_BAR; PG8_SCHED;
            PG8_LDB(B0, 1, 0); PG8_LDB(B1, 1, 1); PG8_SCHED; PG8_LDA(At, 1, 0); PG8_STAGE(PG8_SA(0, 1), a2 + hstep, voffA);
            PG8_WAIT_V(8); PG8_WAIT_L(0); PG8_BAR; PG8_MMA(0, 0, At, B0); PG8_MMA(0, 1, At, B1); PG8_BAR; PG8_SCHED;
            PG8_LDA(At, 1, 1); PG8_STAGE(PG8_SB(1, 0), b3, voffB); PG8_STAGE(PG8_SB(1, 1), b3 + hstep, voffB); PG8_STAGE(PG8_SA(1, 0), a3, voffA);
            PG8_WAIT_V(8); PG8_WAIT_L(0); PG8_BAR; PG8_MMA(1, 0, At, B0); PG8_MMA(1, 1, At, B1); PG8_BAR; PG8_SCHED;
            } else {
            PG8_LDB(B0, 0, 0); PG8_SCHED; PG8_LDA(At, 0, 0); PG8_STAGE(PG8_SA(1, 1), a1 + hstep, voffA);
            PG8_WAIT_L(8); PG8_BAR; PG8_WAIT_L(0); PG8_MMA(0, 0, At, B0); PG8_BAR; PG8_SCHED;
            PG8_LDB(B1, 0, 1); PG8_STAGE(PG8_SB(0, 0), b2, voffB);
            PG8_BAR; PG8_WAIT_L(0); PG8_MMA(0, 1, At, B1); PG8_BAR;
            PG8_LDA(At, 0, 1); PG8_STAGE(PG8_SA(0, 0), a2, voffA);
            PG8_BAR; PG8_WAIT_L(0); PG8_MMA(1, 0, At, B0); PG8_BAR; PG8_SCHED;
            PG8_STAGE(PG8_SB(0, 1), b2 + hstep, voffB);
            PG8_WAIT_V(6); PG8_BAR; PG8_MMA(1, 1, At, B1); PG8_BAR;
            PG8_LDB(B0, 1, 0); PG8_SCHED; PG8_LDA(At, 1, 0); PG8_STAGE(PG8_SA(0, 1), a2 + hstep, voffA);
            PG8_WAIT_L(8); PG8_BAR; PG8_WAIT_L(0); PG8_MMA(0, 0, At, B0); PG8_BAR; PG8_SCHED;
            PG8_LDB(B1, 1, 1); PG8_STAGE(PG8_SB(1, 0), b3, voffB);
            PG8_BAR; PG8_WAIT_L(0); PG8_MMA(0, 1, At, B1); PG8_BAR;
            PG8_LDA(At, 1, 1); PG8_STAGE(PG8_SA(1, 0), a3, voffA);
            PG8_BAR; PG8_WAIT_L(0); PG8_MMA(1, 0, At, B0); PG8_BAR; PG8_SCHED;
            PG8_STAGE(PG8_SB(1, 1), b3 + hstep, voffB);
            PG8_WAIT_V(6); PG8_BAR; PG8_MMA(1, 1, At, B1); PG8_BAR;
            }
        }
        if constexpr (ALIGN_EPI) { if (wr == 0) PG8_BAR; }
        if (cur.split > 1) {
            float* ab = S.acc_buf + (size_t)cur.pn * (64 * 512) + tid;
#pragma unroll
            for (int m = 0; m < 4; ++m)
#pragma unroll
                for (int bj = 0; bj < 2; ++bj)
#pragma unroll
                    for (int n = 0; n < 2; ++n)
#pragma unroll
                        for (int c = 0; c < 4; ++c) unsafeAtomicAdd(ab + (((m * 2 + bj) * 2 + n) * 4 + c) * 512, acc[0][bj][m][n][c]);
            __threadfence();
            PG8_LAS unsigned* flag = (PG8_LAS unsigned*)(lds + STAGE_BYTES);
            PG8_BAR;
            if (tid == 0) { const unsigned old = __hip_atomic_fetch_add(S.cnt + cur.pn, 1u, __ATOMIC_ACQ_REL, __HIP_MEMORY_SCOPE_AGENT); *flag = (old == (unsigned)cur.split - 1u) ? 1u : 0u; }
            asm volatile("s_waitcnt lgkmcnt(0)" ::: "memory"); PG8_BAR; asm volatile("" ::: "memory");
            const bool lastone = *flag != 0u;
            asm volatile("s_waitcnt lgkmcnt(0)" ::: "memory"); PG8_BAR;
            if (lastone) { __threadfence();
#pragma unroll
                for (int m = 0; m < 4; ++m)
#pragma unroll
                    for (int bj = 0; bj < 2; ++bj)
#pragma unroll
                        for (int n = 0; n < 2; ++n) {
#pragma unroll
                            for (int c = 0; c < 4; ++c) acc[0][bj][m][n][c] = __hip_atomic_load(ab + (((m * 2 + bj) * 2 + n) * 4 + c) * 512, __ATOMIC_RELAXED, __HIP_MEMORY_SCOPE_AGENT);
                            acc[1][bj][m][n] = (f32x4){0.f, 0.f, 0.f, 0.f}; }
                E(acc, cur, wr, wc, fr, fq); }
        } else
        if constexpr (!Epi::AFTER_DRAIN) { E(acc, cur, wr, wc, fr, fq); S.done(cur); }
        if (!has_next) break;
#pragma unroll
        for (int a = 0; a < 2; ++a)
#pragma unroll
            for (int b = 0; b < 2; ++b)
#pragma unroll
                for (int m = 0; m < 4; ++m)
#pragma unroll
                    for (int n = 0; n < 2; ++n) acc[a][b][m][n] = (f32x4){0.f, 0.f, 0.f, 0.f};
        cur = nxt; cA = nA; cB = nB; ++ui;
        if constexpr (ALIGN_EPI) { if (wr == 1) PG8_BAR; }
    }
    if constexpr (Bg::PER != 0) { if (bg.rounds > 0) asm volatile("global_store_dwordx4 %1, %0, off nt" :: "v"(bgdata), "v"(bgdst) : "memory"); }
    PG8_WAIT_V(0);
    if constexpr (!ALIGN_EPI) { if (wr == 0) PG8_BAR; }
    PG8_BAR;
    if constexpr (Epi::AFTER_DRAIN) { E.fused(acc, cur, wr, wc, fr, fq, lds, wid, lane); S.done(cur); }
#undef PG8_SA
#undef PG8_SB
#undef PG8_STAGE
#undef PG8_LDA
#undef PG8_LDB
#undef PG8_MMA
#undef PG8_WAIT_V
#undef PG8_WAIT_L
#undef PG8_BAR
#undef PG8_SCHED
}
}

#ifndef PG8_SP2
#define PG8_SP2 true
#endif
#define LAS __attribute__((address_space(3)))
typedef unsigned short bf16;
typedef pg8::f32x4 f32x4;
typedef pg8::u32x4 u32x4;
typedef pg8::bf16x8 bf16x8;
typedef unsigned u32x2 __attribute__((ext_vector_type(2)));
typedef float f32x16 __attribute__((ext_vector_type(16)));
typedef short s16x4 __attribute__((ext_vector_type(4)));
using pg8::cvt_pk_bf16;

constexpr int DM = 1024, DFF = 2816, SEQ = 2048, MPR = 32768, NS = 128, MV = MPR + NS, MP = 33024, INW = 5120;
constexpr float EPS = 1e-6f;
constexpr float LOG2E = 1.4426950408889634f, LN2 = 0.6931471805599453f;
constexpr float QSCALE = 0.125f * LOG2E;
constexpr size_t MiB = 1u << 20;
constexpr size_t WS_SS1 = 0, WS_SS2 = 256 * 1024, WS_SS3 = 512 * 1024, WS_GT = 768 * 1024;
constexpr size_t WS_W1GU = 1 * MiB, WS_W1D = 13 * MiB, WS_WIN = 19 * MiB, WS_WUA = 29 * MiB, WS_WUB = 30 * MiB, WS_WO = 31 * MiB, WS_W2GU = 33 * MiB, WS_W2D = 45 * MiB;
constexpr size_t WS_XB = 52 * MiB, WS_H = 117 * MiB, WS_X1 = 295 * MiB, WS_X1B = 424 * MiB, WS_QP = 489 * MiB, WS_KP = 569 * MiB, WS_VP = 625 * MiB, WS_QS = 681 * MiB;
constexpr size_t WS_G = 682 * MiB, WS_XAB = 912 * MiB, WS_OB3 = 844 * MiB, WS_LSE3 = 893 * MiB, WS_MIXB = 1041 * MiB, WS_X2B = 1106 * MiB, WS_DUMP = 1171 * MiB, WS_ACC = 1174 * MiB, WS_BAR = 1176 * MiB, WS_END = 1177 * MiB;
constexpr size_t ACC_FLOATS = 4 * 64 * 512;
constexpr size_t O_YP = 0, O_YS = 33554432, O_AP = 33685504, O_B1P = 34209792, O_B2P = 35258368, O_B3P = 39452672, O_AS = 56229888, O_B1S = 60424192, O_B2S = 68812800, O_B3S = 102367232;

constexpr int ATT_KROW = 144, ATT_HALF = 2 * 256 * ATT_KROW, ATT_PL = 2 * ATT_HALF;
constexpr int LDS_BYTES = ATT_PL + 8 * 1024;

__device__ __forceinline__ int tid_now_(int wave_sg) { int t; asm volatile("v_mbcnt_lo_u32_b32 %0, -1, 0\n\tv_mbcnt_hi_u32_b32 %0, -1, %0\n\tv_lshl_or_b32 %0, %1, 6, %0" : "=&v"(t) : "s"(wave_sg)); return t; }
#define TID_NOW(wave_sg) tid_now_(wave_sg)
struct Params {
    const float* in[24];
    float* out;
    unsigned char* ws;
};
typedef const __attribute__((address_space(4))) Params* KParams;
#define XB_TMO      128
#define XB_XCNT(j)  (256  + 64 * (j))
#define XB_XSUB(j)  (1280 + 64 * (j))
#define XB_XGEN(j)  (2304 + 64 * (j))
#define XB_TOP      3328
#define XB_TOPGEN   3392
#define XCD_BAR_WORDS 3456
#define XB_SPIN_CAP (1u << 18)

__device__ __forceinline__ unsigned xb_ld(unsigned* p)              { return __hip_atomic_load(p, __ATOMIC_RELAXED, __HIP_MEMORY_SCOPE_AGENT); }
__device__ __forceinline__ unsigned xb_add(unsigned* p, unsigned v) { return __hip_atomic_fetch_add(p, v, __ATOMIC_RELAXED, __HIP_MEMORY_SCOPE_AGENT); }
__device__ __forceinline__ unsigned xb_xcc_id() { return (unsigned)__builtin_amdgcn_s_getreg((3 << 11) | 20) & 0xFu; }
#define XB_SPIN(cond, bar) do { unsigned _sp = 0; while (cond) { __builtin_amdgcn_s_sleep(1); \
    if ((++_sp & 255u) == 0u) { if (xb_ld(&(bar)[XB_TMO])) break; if (_sp > XB_SPIN_CAP) { atomicAdd(&(bar)[XB_TMO], 1u); break; } } } } while (0)

struct XcdBarrier {
    unsigned* bar; unsigned x;
    volatile LAS unsigned* st;
};

__device__ __forceinline__ XcdBarrier xcd_barrier_post(unsigned* bar, volatile LAS unsigned* st, int wave_sg) {
    XcdBarrier b; b.bar = bar; b.x = xb_xcc_id(); b.st = st;
    if (TID_NOW(wave_sg) == 0) (void)xb_add(&bar[XB_XCNT(b.x)], 1u);
    return b;
}
__device__ __forceinline__ void xcd_barrier_complete(unsigned* bar, unsigned x, unsigned& nloc, unsigned& nx) {
    const unsigned G = gridDim.x * gridDim.y * gridDim.z;
    unsigned sum, cnt, mine, sp = 0u;
    for (;;) {
        sum = 0u; cnt = 0u; mine = 0u;
#pragma unroll
        for (unsigned j = 0; j < 16; ++j) { const unsigned c = xb_ld(&bar[XB_XCNT(j)]); sum += c; cnt += (c > 0u) ? 1u : 0u; mine = (j == x) ? c : mine; }
        if (sum == G) break;
        __builtin_amdgcn_s_sleep(1);
        if ((++sp & 255u) == 0u) { if (xb_ld(&bar[XB_TMO])) break; if (sp > XB_SPIN_CAP) { atomicAdd(&bar[XB_TMO], 1u); break; } }
    }
    nloc = mine > 0u ? mine : 1u; nx = cnt > 0u ? cnt : 1u;
}

__device__ __forceinline__ void xcd_barrier(const XcdBarrier& b, int wave_sg) {
    asm volatile("s_waitcnt vmcnt(0)" ::: "memory");
    __syncthreads();
    if (TID_NOW(wave_sg) == 0) {
        unsigned* bar = b.bar;
        __builtin_amdgcn_s_waitcnt(0);
        unsigned nloc = b.st[0], nx = b.st[1];
        if (nloc == 0u) { xcd_barrier_complete(bar, b.x, nloc, nx); b.st[0] = nloc; b.st[1] = nx; }
        const unsigned old = xb_add(&bar[XB_XSUB(b.x)], 1u);
        const unsigned gen = old / nloc;
        if (old + 1u == (gen + 1u) * nloc) {
            __builtin_amdgcn_fence(__ATOMIC_RELEASE, "agent");
            asm volatile("s_waitcnt vmcnt(0)" ::: "memory");
            const unsigned og = xb_add(&bar[XB_TOP], 1u);
            const unsigned tg = og / nx;
            if (og + 1u == (tg + 1u) * nx) xb_add(&bar[XB_TOPGEN], 1u);
            else XB_SPIN(xb_ld(&bar[XB_TOPGEN]) == tg, bar);
            __builtin_amdgcn_fence(__ATOMIC_ACQUIRE, "agent");
            xb_add(&bar[XB_XGEN(b.x)], 1u);
            asm volatile("s_waitcnt vmcnt(0)" ::: "memory");
        } else {
            XB_SPIN(xb_ld(&bar[XB_XGEN(b.x)]) == gen, bar);
            __builtin_amdgcn_fence(__ATOMIC_ACQUIRE, "agent");
            asm volatile("s_waitcnt vmcnt(0)" ::: "memory");
        }
    }
    __syncthreads();
}


__device__ __forceinline__ float wave_sum(float v) {
#pragma unroll
    for (int o = 1; o < 64; o <<= 1) v += __shfl_xor(v, o);
    return v;
}
__device__ __forceinline__ float wave_max(float v) {
#pragma unroll
    for (int o = 1; o < 64; o <<= 1) v = fmaxf(v, __shfl_xor(v, o));
    return v;
}
__device__ __forceinline__ float bf2f(unsigned short b) { return __builtin_bit_cast(float, (unsigned)b << 16); }
__device__ __forceinline__ float sigmoidf_(float x) { return __builtin_amdgcn_rcpf(1.f + __builtin_amdgcn_exp2f(-x * LOG2E)); }

__device__ __forceinline__ void tr_item(const float* __restrict__ W, int ldw, int k0, int ns0, bf16* WT, int K, int nd0, const float* __restrict__ gain, LAS float* scr, int lane) {
#pragma unroll 16
    for (int i = 0; i < 32; ++i) { const int kk = 2 * i + (lane >> 5); float w = W[(size_t)(k0 + kk) * ldw + ns0 + (lane & 31)]; if (gain) w *= gain[k0 + kk]; scr[kk * 33 + (lane & 31)] = w; }
    asm volatile("s_waitcnt lgkmcnt(0)" ::: "memory");
    const int c = lane & 7;
#pragma unroll
    for (int j = 0; j < 4; ++j) { const int n = (lane >> 3) + 8 * j; const LAS float* s = scr + (8 * c) * 33 + n;
        u32x4 o; o.x = cvt_pk_bf16(s[0 * 33], s[1 * 33]); o.y = cvt_pk_bf16(s[2 * 33], s[3 * 33]); o.z = cvt_pk_bf16(s[4 * 33], s[5 * 33]); o.w = cvt_pk_bf16(s[6 * 33], s[7 * 33]);
        *(u32x4*)(WT + (size_t)(nd0 + n) * K + k0 + 8 * c) = o; }
    asm volatile("s_waitcnt lgkmcnt(0)" ::: "memory");
}
template <int L, int R> __device__ __forceinline__ void copy_seg(const float* __restrict__ src, float* __restrict__ dst, unsigned lo, unsigned hi, unsigned t0, unsigned nthr) {
    constexpr unsigned PER = (unsigned)(L - 1) * R / 4, LR4 = (unsigned)L * R / 4, R4 = R / 4;
    const f32x4* s4 = (const f32x4*)src; f32x4* d4 = (f32x4*)dst;
    unsigned i = lo + t0;
    for (; i + 3 * nthr < hi; i += 4 * nthr) {
        f32x4 v[4];
#pragma unroll
        for (int u = 0; u < 4; ++u) { const unsigned ii = i + u * nthr, n = ii / PER, j = ii - n * PER; v[u] = __builtin_nontemporal_load(s4 + (size_t)n * LR4 + R4 + j); }
#pragma unroll
        for (int u = 0; u < 4; ++u) { const unsigned ii = i + u * nthr, n = ii / PER, j = ii - n * PER; __builtin_nontemporal_store(v[u], d4 + (size_t)n * LR4 + j); }
    }
    for (; i < hi; i += nthr) { const unsigned n = i / PER, j = i - n * PER; __builtin_nontemporal_store(__builtin_nontemporal_load(s4 + (size_t)n * LR4 + R4 + j), d4 + (size_t)n * LR4 + j); }
}
constexpr unsigned CP_S0 = 128u * 127 * 64, CP_S1 = CP_S0 + 128u * 127 * 128, CP_S2 = CP_S1 + 128u * 511 * 128, CP_TOT = CP_S2 + 128u * 2047 * 128;
__device__ __forceinline__ void copy_slice(KParams P, unsigned lo, unsigned hi, unsigned t0, unsigned nthr) {
    if (lo < CP_S0 && hi > 0) copy_seg<128, 256>(P->in[2], P->out + O_AS, lo, hi < CP_S0 ? hi : CP_S0, t0, nthr);
    if (lo < CP_S1 && hi > CP_S0) copy_seg<128, 512>(P->in[3], P->out + O_B1S, (lo > CP_S0 ? lo : CP_S0) - CP_S0, (hi < CP_S1 ? hi : CP_S1) - CP_S0, t0, nthr);
    if (lo < CP_S2 && hi > CP_S1) copy_seg<512, 512>(P->in[4], P->out + O_B2S, (lo > CP_S1 ? lo : CP_S1) - CP_S1, (hi < CP_S2 ? hi : CP_S2) - CP_S1, t0, nthr);
    if (lo < CP_TOT && hi > CP_S2) copy_seg<2048, 512>(P->in[5], P->out + O_B3S, (lo > CP_S2 ? lo : CP_S2) - CP_S2, (hi < CP_TOT ? hi : CP_TOT) - CP_S2, t0, nthr);
}
constexpr unsigned cp_cut(double f) { return (unsigned)(f * (double)CP_TOT) & ~3u; }
constexpr unsigned CPC0 = 0, CPC1 = cp_cut(0.15), CPC2 = cp_cut(0.235), CPC3 = cp_cut(0.485), CPC4 = cp_cut(0.571), CPC5 = cp_cut(0.663), CPC6 = cp_cut(0.75), CPC7 = CP_TOT;
__device__ __forceinline__ void idle_copy(KParams P, int nwg, unsigned lo, unsigned hi, const int wave_sg) {
    const int G = gridDim.x, busy = nwg % G; const int tid = TID_NOW(wave_sg);
    if (busy == 0 || (int)blockIdx.x < busy) { if (busy == 0) copy_slice(P, lo, hi, blockIdx.x * 512 + tid, G * 512); return; }
    copy_slice(P, lo, hi, (blockIdx.x - busy) * 512 + tid, (G - busy) * 512);
}
__device__ __forceinline__ void phase_prologue(KParams P, LAS unsigned char* lds, const int wave_sg) {
    const int tid = TID_NOW(wave_sg), lane = tid & 63, wave = wave_sg;
    const int gw = blockIdx.x * 8 + wave, NGW = gridDim.x * 8;
    unsigned char* ws = P->ws;
    LAS float* scr = (LAS float*)(lds + wave * 16384);
    constexpr int I_GU = 16 * 176, I_D = 44 * 32, I_IN = 16 * 160, I_UA = 8 * 32, I_UB = 4 * 32, I_O = 16 * 32;
    constexpr int NITEMS = 2 * I_GU + 2 * I_D + I_IN + I_UA + I_UB + I_O;
    for (int it = gw; it < NITEMS; it += NGW) {
        int r = it;
        if (r < 2 * I_GU) { const int L = r / I_GU; r -= L * I_GU; const int kb = r / 176, nb = r % 176, nd0 = 32 * nb, pn = nd0 >> 8, bj = (nd0 >> 7) & 1, c = nd0 & 127;
            const float* W = P->in[L ? (bj ? 22 : 21) : (bj ? 8 : 7)];
            tr_item(W, DFF, 64 * kb, 128 * pn + c, (bf16*)(ws + (L ? WS_W2GU : WS_W1GU)), DM, nd0, P->in[L ? 20 : 6], scr, lane); continue; }
        r -= 2 * I_GU;
        if (r < 2 * I_D) { const int L = r / I_D; r -= L * I_D; const int kb = r / 32, nb = r % 32;
            tr_item(P->in[L ? 23 : 9], DM, 64 * kb, 32 * nb, (bf16*)(ws + (L ? WS_W2D : WS_W1D)), DFF, 32 * nb, nullptr, scr, lane); continue; }
        r -= 2 * I_D;
        if (r < I_IN) { const int kb = r / 160, nb = r % 160, nd0 = 32 * nb; int ns0 = nd0;
            if (nd0 < 3072) { const int pn = nd0 >> 8, cl = nd0 & 255, bj = cl >> 7, wc = (cl >> 5) & 3; ns0 = 64 * (4 * pn + wc) + 32 * bj; }
            tr_item(P->in[11], INW, 64 * kb, ns0, (bf16*)(ws + WS_WIN), DM, nd0, P->in[10], scr, lane); continue; }
        r -= I_IN;
        if (r < I_UA) { const int kb = r / 32, nb = r % 32; tr_item(P->in[17], DM, 64 * kb, 32 * nb, (bf16*)(ws + WS_WUA), 768, 32 * nb, nullptr, scr, lane); continue; }
        r -= I_UA;
        if (r < I_UB) { const int kb = r / 32, nb = r % 32; tr_item(P->in[18], DM, 64 * kb, 32 * nb, (bf16*)(ws + WS_WUA) + 512, 768, 32 * nb, nullptr, scr, lane); continue; }
        r -= I_UB;
        { const int kb = r / 32, nb = r % 32; tr_item(P->in[19], DM, 64 * kb, 32 * nb, (bf16*)(ws + WS_WO), DM, 32 * nb, nullptr, scr, lane); }
    }
    float* ss1 = (float*)(ws + WS_SS1); float* ss2 = (float*)(ws + WS_SS2); float* ss3 = (float*)(ws + WS_SS3);
    bf16* XB = (bf16*)(ws + WS_XB);
    for (int m = gw; m < MP; m += NGW) {
        unsigned long long* o8 = (unsigned long long*)(XB + (size_t)m * DM) + lane;
        if (m < MV) {
            const float* xr = (m < MPR) ? P->in[0] + (size_t)m * DM : P->in[1] + (size_t)(m - MPR) * DM;
            const f32x4* x4 = (const f32x4*)xr + lane; f32x4 v[4]; float s = 0.f;
#pragma unroll
            for (int j = 0; j < 4; ++j) { v[j] = x4[64 * j]; s += (v[j].x * v[j].x + v[j].y * v[j].y) + (v[j].z * v[j].z + v[j].w * v[j].w); }
            s = wave_sum(s);
#pragma unroll
            for (int j = 0; j < 4; ++j) o8[64 * j] = (unsigned long long)cvt_pk_bf16(v[j].x, v[j].y) | ((unsigned long long)cvt_pk_bf16(v[j].z, v[j].w) << 32);
            if (lane == 0) ss1[m] = s;
        } else {
#pragma unroll
            for (int j = 0; j < 4; ++j) o8[64 * j] = 0ull;
            if (lane == 0) ss1[m] = 0.f;
        }
    }
    const long gtid = (long)blockIdx.x * 512 + tid, gthreads = (long)gridDim.x * 512;
    for (long i = gtid; i < MP; i += gthreads) { ss2[i] = 0.f; ss3[i] = 0.f; }
    for (long i = gtid; i < (long)(3 * ACC_FLOATS + 3 * 64); i += gthreads) ((float*)(ws + WS_ACC))[i] = 0.f;
    if (blockIdx.x == 0 && tid < 320) { float* GT = (float*)(ws + WS_GT); const int r = tid >> 6, d = tid & 63;
        float v = 1.f; if (r == 0) v = P->in[12][d] * QSCALE; else if (r == 1) v = P->in[13][d]; else if (r == 2) v = P->in[14][d] * QSCALE; else if (r == 3) v = P->in[15][d];
        GT[tid] = v; }
    if (gridDim.x != 256) copy_slice(P, 0u, CP_TOT, (unsigned)gtid, (unsigned)gthreads);
}

struct EpiSwiGLU {
    static constexpr bool PERM = true, AFTER_DRAIN = false; static constexpr int HOOK_T = -1;
    bf16* H; const float* ss;
    __device__ __forceinline__ void operator()(const f32x4 (&acc)[2][2][4][2], const pg8::Unit& u, int wr, int wc, int fr, int fq) const {
        const int row0 = u.pm * 256 + wr * 64 + fr, col0 = u.pn * 128 + wc * 32 + 8 * fq;
#pragma unroll
        for (int ai = 0; ai < 2; ++ai)
#pragma unroll
            for (int m = 0; m < 4; ++m) { const int row = row0 + ai * 128 + m * 16; const float rs = __builtin_amdgcn_rsqf(ss[row] * (1.f / DM) + EPS);
                float h[8];
#pragma unroll
                for (int n = 0; n < 2; ++n)
#pragma unroll
                    for (int j = 0; j < 4; ++j) { const float g = acc[ai][0][m][n][j] * rs, up = acc[ai][1][m][n][j] * rs; h[4 * n + j] = g * sigmoidf_(g) * up; }
                u32x4 w; w.x = cvt_pk_bf16(h[0], h[1]); w.y = cvt_pk_bf16(h[2], h[3]); w.z = cvt_pk_bf16(h[4], h[5]); w.w = cvt_pk_bf16(h[6], h[7]);
                *(u32x4*)(H + (size_t)row * DFF + col0) = w; }
    }
};
template <bool RESB, bool OUTF> struct EpiRes {
    static constexpr bool PERM = false, AFTER_DRAIN = false; static constexpr int HOOK_T = -1;
    const float* res_p; const float* res_s; const bf16* resb; float* out; bf16* outb; float* ss; float scale;
    __device__ __forceinline__ void operator()(const f32x4 (&acc)[2][2][4][2], const pg8::Unit& u, int wr, int wc, int fr, int fq) const {
        const int row0 = u.pm * 256 + wr * 64 + fr, col0 = u.pn * 256 + wc * 32 + 4 * fq;
#pragma unroll
        for (int ai = 0; ai < 2; ++ai)
#pragma unroll
            for (int m = 0; m < 4; ++m) { const int row = row0 + ai * 128 + m * 16;
                if (row < MV) {
                    const float* rp = (row < MPR) ? res_p + (size_t)row * DM : res_s + (size_t)(row - MPR) * DM;
                    float s = 0.f;
#pragma unroll
                    for (int bj = 0; bj < 2; ++bj)
#pragma unroll
                        for (int n = 0; n < 2; ++n) { const int col = col0 + bj * 128 + n * 16; f32x4 r;
                            if (RESB) { const u32x2 rw = *(const u32x2*)(resb + (size_t)row * DM + col); r = (f32x4){bf2f(rw.x & 0xffff), bf2f(rw.x >> 16), bf2f(rw.y & 0xffff), bf2f(rw.y >> 16)}; }
                            else r = *(const f32x4*)(rp + col);
                            const f32x4 v = r + acc[ai][bj][m][n] * scale;
                            if (OUTF) *(f32x4*)(out + (size_t)row * DM + col) = v;
                            else { u32x2 w; w.x = cvt_pk_bf16(v[0], v[1]); w.y = cvt_pk_bf16(v[2], v[3]); *(u32x2*)(outb + (size_t)row * DM + col) = w;
                                s += (v[0] * v[0] + v[1] * v[1]) + (v[2] * v[2] + v[3] * v[3]); } }
                    if (!OUTF) { s += __shfl_xor(s, 16); s += __shfl_xor(s, 32); if (fq == 0) atomicAdd(ss + row, s); }
                }
            }
    }
};
struct EpiQKV {
    static constexpr bool PERM = false, AFTER_DRAIN = false; static constexpr int HOOK_T = -1;
    const float* ss; unsigned char* wsb; bf16* G; float* dout; const float* GT;
    __device__ __forceinline__ void operator()(const f32x4 (&acc)[2][2][4][2], const pg8::Unit& u, int wr, int wc, int fr, int fq) const {
        const int row0 = u.pm * 256 + wr * 64 + fr;
        if (u.pn >= 12) {
            const int col0 = (u.pn - 12) * 256 + wc * 32 + 4 * fq;
#pragma unroll
            for (int ai = 0; ai < 2; ++ai)
#pragma unroll
                for (int m = 0; m < 4; ++m) { const int row = row0 + ai * 128 + m * 16; const float rs = __builtin_amdgcn_rsqf(ss[row] * (1.f / DM) + EPS);
#pragma unroll
                    for (int bj = 0; bj < 2; ++bj)
#pragma unroll
                        for (int n = 0; n < 2; ++n) { const f32x4 a = acc[ai][bj][m][n] * rs; u32x2 w; w.x = cvt_pk_bf16(sigmoidf_(a[0]), sigmoidf_(a[1])); w.y = cvt_pk_bf16(sigmoidf_(a[2]), sigmoidf_(a[3]));
                            *(u32x2*)(G + (size_t)row * 2048 + col0 + bj * 128 + n * 16) = w; } }
            return;
        }
        const int hd = 4 * u.pn + wc;
        const bool isA = hd < 12; const int hb = isA ? 0 : hd - 12, t = hb / 12, jj = hb - 12 * t, g = isA ? 0 : (jj >> 2);
        const int kind = isA ? ((hd >= 8) + (hd >= 10)) : t;
        const int hs = isA ? (hd & 1) : (jj & 3), H = isA ? 2 : 4;
        const int idx = isA ? (kind == 0 ? hd : hs) : ((kind == 0 ? 8 : 2) + jj);
        const int sh = 2 * g, dil = 1 << sh, win = 128 << sh;
        const size_t so_p = isA ? O_AP : (O_B1P + (g > 0 ? O_B2P - O_B1P : 0) + (g > 1 ? O_B3P - O_B2P : 0));
        const size_t so_s = isA ? O_AS : (O_B1S + (g > 0 ? O_B2S - O_B1S : 0) + (g > 1 ? O_B3S - O_B2S : 0));
        const int gi = (kind == 2) ? 4 : ((isA ? 0 : 2) + kind);
        const size_t boff = WS_QP + (kind > 0 ? WS_KP - WS_QP : 0) + (kind > 1 ? WS_VP - WS_KP : 0); const int nh = kind == 0 ? 20 : 14;
        f32x4 gv[2][2];
#pragma unroll
        for (int bj = 0; bj < 2; ++bj)
#pragma unroll
            for (int n = 0; n < 2; ++n) gv[bj][n] = *(const f32x4*)(GT + gi * 64 + 32 * bj + 16 * n + 4 * fq);
#pragma unroll
        for (int ai = 0; ai < 2; ++ai)
#pragma unroll
            for (int m = 0; m < 4; ++m) { const int row = row0 + ai * 128 + m * 16; const float rs = __builtin_amdgcn_rsqf(ss[row] * (1.f / DM) + EPS);
                f32x4 v[2][2]; float s = 0.f;
#pragma unroll
                for (int bj = 0; bj < 2; ++bj)
#pragma unroll
                    for (int n = 0; n < 2; ++n) { v[bj][n] = acc[ai][bj][m][n] * rs; s += (v[bj][n][0] * v[bj][n][0] + v[bj][n][1] * v[bj][n][1]) + (v[bj][n][2] * v[bj][n][2] + v[bj][n][3] * v[bj][n][3]); }
                s += __shfl_xor(s, 16); s += __shfl_xor(s, 32);
                const float inv = (kind < 2) ? __builtin_amdgcn_rsqf(s * (1.f / 64.f) + EPS) : 1.f;
#pragma unroll
                for (int bj = 0; bj < 2; ++bj)
#pragma unroll
                    for (int n = 0; n < 2; ++n) v[bj][n] = v[bj][n] * gv[bj][n] * inv;
                if (row < MPR) {
                    const int b = row >> 11, sq = row & 2047, p = ((sq & (dil - 1)) << (11 - sh)) + (sq >> sh);
                    bf16* dst = (bf16*)(wsb + boff) + ((size_t)(b * nh + idx) * 2048 + p) * 64;
#pragma unroll
                    for (int bj = 0; bj < 2; ++bj)
#pragma unroll
                        for (int n = 0; n < 2; ++n) { u32x2 w; w.x = cvt_pk_bf16(v[bj][n][0], v[bj][n][1]); w.y = cvt_pk_bf16(v[bj][n][2], v[bj][n][3]); *(u32x2*)(dst + 32 * bj + 16 * n + 4 * fq) = w; }
                    if (kind > 0 && sq >= 2048 - win) {
                        float* sd = dout + so_p + ((((size_t)b * win + (sq - (2048 - win))) * 2 + (kind - 1)) * H + hs) * 64;
#pragma unroll
                        for (int bj = 0; bj < 2; ++bj)
#pragma unroll
                            for (int n = 0; n < 2; ++n) *(f32x4*)(sd + 32 * bj + 16 * n + 4 * fq) = v[bj][n];
                    }
                } else if (row < MV) {
                    const int nn = row - MPR;
                    if (kind == 0) { float* sd = (float*)(wsb + WS_QS) + ((size_t)nn * 20 + idx) * 64;
#pragma unroll
                        for (int bj = 0; bj < 2; ++bj)
#pragma unroll
                            for (int n = 0; n < 2; ++n) *(f32x4*)(sd + 32 * bj + 16 * n + 4 * fq) = v[bj][n];
                    } else { float* sd = dout + so_s + ((((size_t)nn * win + (win - 1)) * 2 + (kind - 1)) * H + hs) * 64;
#pragma unroll
                        for (int bj = 0; bj < 2; ++bj)
#pragma unroll
                            for (int n = 0; n < 2; ++n) *(f32x4*)(sd + 32 * bj + 16 * n + 4 * fq) = v[bj][n];
                    }
                }
            }
    }
};
struct EpiUp {
    static constexpr bool PERM = true, AFTER_DRAIN = false; static constexpr int HOOK_T = 8;
    const bf16* G; bf16* MIXB;
    __device__ __forceinline__ void hook(f32x4 (&acc)[2][2][4][2], const pg8::Unit& u, int wr, int wc, int fr_, int fq) const {
        int fr = fr_; asm volatile("" : "+v"(fr));
        const int row0 = u.pm * 256 + wr * 64 + fr, col0 = u.pn * 256 + wc * 32 + 8 * fq;
#pragma unroll
        for (int ai = 0; ai < 2; ++ai)
#pragma unroll
            for (int m = 0; m < 4; ++m) { const int row = row0 + ai * 128 + m * 16;
#pragma unroll
                for (int bj = 0; bj < 2; ++bj) { const int col = col0 + bj * 128;
                    const unsigned goff = (unsigned)(row * 2048 + col) * 2u;
                    const u32x4 ga = *(const u32x4*)((const char*)G + goff), gb = *(const u32x4*)((const char*)G + goff + 2048u);
#define RT(a, b) ((a) * __builtin_amdgcn_rcpf(fmaxf((b), 1e-20f)))
                    const f32x4 r0 = {RT(bf2f(ga.x & 0xffff), bf2f(gb.x & 0xffff)), RT(bf2f(ga.x >> 16), bf2f(gb.x >> 16)), RT(bf2f(ga.y & 0xffff), bf2f(gb.y & 0xffff)), RT(bf2f(ga.y >> 16), bf2f(gb.y >> 16))};
                    const f32x4 r1 = {RT(bf2f(ga.z & 0xffff), bf2f(gb.z & 0xffff)), RT(bf2f(ga.z >> 16), bf2f(gb.z >> 16)), RT(bf2f(ga.w & 0xffff), bf2f(gb.w & 0xffff)), RT(bf2f(ga.w >> 16), bf2f(gb.w >> 16))};
#undef RT
                    acc[ai][bj][m][0] = acc[ai][bj][m][0] * r0; acc[ai][bj][m][1] = acc[ai][bj][m][1] * r1;
                    asm volatile("" ::: "memory"); } }
    }
    __device__ __forceinline__ void operator()(const f32x4 (&acc)[2][2][4][2], const pg8::Unit& u, int wr, int wc, int fr, int fq) const {
        const int row0 = u.pm * 256 + wr * 64 + fr, col0 = u.pn * 256 + wc * 32 + 8 * fq;
#pragma unroll
        for (int ai = 0; ai < 2; ++ai)
#pragma unroll
            for (int m = 0; m < 4; ++m) { const int row = row0 + ai * 128 + m * 16;
#pragma unroll
                for (int bj = 0; bj < 2; ++bj) { const int col = col0 + bj * 128;
                    const u32x4 gb = *(const u32x4*)(G + (size_t)row * 2048 + 1024 + col);
                    const f32x4 g0 = {fmaxf(bf2f(gb.x & 0xffff), 1e-20f), fmaxf(bf2f(gb.x >> 16), 1e-20f), fmaxf(bf2f(gb.y & 0xffff), 1e-20f), fmaxf(bf2f(gb.y >> 16), 1e-20f)};
                    const f32x4 g1 = {fmaxf(bf2f(gb.z & 0xffff), 1e-20f), fmaxf(bf2f(gb.z >> 16), 1e-20f), fmaxf(bf2f(gb.w & 0xffff), 1e-20f), fmaxf(bf2f(gb.w >> 16), 1e-20f)};
                    const f32x4 v0 = acc[ai][bj][m][0] * g0, v1 = acc[ai][bj][m][1] * g1;
                    u32x4 w; w.x = cvt_pk_bf16(v0[0], v0[1]); w.y = cvt_pk_bf16(v0[2], v0[3]); w.z = cvt_pk_bf16(v1[0], v1[1]); w.w = cvt_pk_bf16(v1[2], v1[3]);
                    *(u32x4*)(MIXB + (size_t)row * DM + col) = w; } }
    }
};

__device__ __forceinline__ int crow_c(int r) { return (r & 3) + 8 * (r >> 2); }
__device__ __forceinline__ s16x4 vtr(const LAS unsigned char* p) { typedef short v4i16_t __attribute__((ext_vector_type(4))); return __builtin_bit_cast(s16x4, __builtin_amdgcn_ds_read_tr16_b64_v4i16((LAS v4i16_t*)p)); }

__device__ __forceinline__ void phase_attention(KParams P, LAS unsigned char* lds, const int wave_sg) {
    const int tid = TID_NOW(wave_sg), lane = tid & 63, wave = wave_sg;
    unsigned char* ws = P->ws;
    const bf16* QP = (const bf16*)(ws + WS_QP); const bf16* KP = (const bf16*)(ws + WS_KP); const bf16* VP = (const bf16*)(ws + WS_VP);
    const float* QS = (const float*)(ws + WS_QS);
    bf16* OA = (bf16*)(ws + WS_XAB); bf16* OB3 = (bf16*)(ws + WS_OB3); float* LSE3 = (float*)(ws + WS_LSE3);
    const float* sinks = P->in[16];
    {
        LAS float* pl = (LAS float*)(lds + ATT_PL) + wave * 192;
        for (int widx = blockIdx.x * 8 + wave; widx < NS * 20; widx += gridDim.x * 8) {
            const int n = widx / 20, hq = widx % 20;
            const float* cache; int H, L, dil, h; size_t so; int g = 0, slot = 0;
            if (hq < 8) { cache = P->in[2]; H = 2; L = 128; dil = 1; h = hq >> 2; so = O_AS; }
            else { const int jj = hq - 8; g = jj >> 2; slot = jj & 3; h = slot; H = 4; dil = 1 << (2 * g); L = 128 * dil; cache = (g > 1) ? P->in[5] : (g > 0 ? P->in[4] : P->in[3]); so = O_B1S + (g > 0 ? O_B2S - O_B1S : 0) + (g > 1 ? O_B3S - O_B2S : 0); }
            const float slope2 = exp2f(-0.4f * (float)(hq + 1)) * LOG2E * (float)dil;
            const float* newk = P->out + so + ((((size_t)n * L + (L - 1)) * 2 + 0) * H + h) * 64;
            const float* newv = newk + H * 64;
            const float* cb = cache + (size_t)n * L * 2 * H * 64;
            const f32x4* q4 = (const f32x4*)(QS + ((size_t)n * 20 + hq) * 64);
            float sv[3];
#pragma unroll
            for (int rd = 0; rd < 3; ++rd) {
                const int mm = lane + 64 * rd; const bool valid = mm <= 128; const int mc = valid ? mm : 0;
                const f32x4* k4 = (const f32x4*)((mc == 0) ? newk : cb + ((size_t)(L - dil * mc) * 2 * H + h) * 64);
                float dot = 0.f;
#pragma unroll
                for (int d = 0; d < 16; ++d) { const f32x4 a = q4[d], b = k4[d]; dot += (a[0] * b[0] + a[1] * b[1]) + (a[2] * b[2] + a[3] * b[3]); }
                sv[rd] = valid ? dot - slope2 * (float)mm : -1e30f;
            }
            float mx = wave_max(fmaxf(fmaxf(sv[0], sv[1]), sv[2]));
            float sink2 = 0.f;
            if (hq < 8) { sink2 = sinks[hq] * LOG2E; mx = fmaxf(mx, sink2); }
            float lsum = 0.f;
#pragma unroll
            for (int rd = 0; rd < 3; ++rd) { const float p = __builtin_amdgcn_exp2f(sv[rd] - mx); pl[lane + 64 * rd] = p; lsum += p; }
            lsum = wave_sum(lsum);
            if (hq < 8) lsum += __builtin_amdgcn_exp2f(sink2 - mx);
            asm volatile("s_waitcnt lgkmcnt(0)" ::: "memory");
            const int kg = lane >> 4, dq = lane & 15;
            f32x4 o4 = {0.f, 0.f, 0.f, 0.f};
#pragma unroll
            for (int i0 = 0; i0 < 33; i0 += 11) {
                f32x4 vv[11]; float pp[11];
#pragma unroll
                for (int i = 0; i < 11; ++i) { const int mm = 4 * (i0 + i) + kg; const int mc = mm <= 128 ? mm : 128;
                    const float* vp = (mc == 0) ? newv : cb + ((size_t)(L - dil * mc) * 2 * H + H + h) * 64;
                    vv[i] = *(const f32x4*)(vp + 4 * dq); pp[i] = pl[mm]; }
#pragma unroll
                for (int i = 0; i < 11; ++i) o4 = o4 + vv[i] * pp[i];
            }
#pragma unroll
            for (int c = 0; c < 4; ++c) { o4[c] += __shfl_xor(o4[c], 16); o4[c] += __shfl_xor(o4[c], 32); }
            const float il = __builtin_amdgcn_rcpf(lsum);
            const size_t row = MPR + n;
            u32x2 ow; ow.x = cvt_pk_bf16(o4[0] * il, o4[1] * il); ow.y = cvt_pk_bf16(o4[2] * il, o4[3] * il);
            if (hq < 8) { if (kg == 0) *(u32x2*)(OA + row * 768 + hq * 64 + 4 * dq) = ow; }
            else { if (kg == 0) *(u32x2*)(OB3 + ((size_t)g * MP + row) * 256 + slot * 64 + 4 * dq) = ow; if (lane == 0) LSE3[((size_t)g * MP + row) * 4 + slot] = (mx + __builtin_amdgcn_logf(lsum)) * LN2; }
            asm volatile("s_waitcnt lgkmcnt(0)" ::: "memory");
        }
    }
    const int half = wave >> 2, w = wave & 3, r32 = lane & 31, hi = lane >> 5, htid = tid & 255;
    LAS unsigned char* Kl = lds + half * ATT_HALF; LAS unsigned char* Vl = Kl + 256 * ATT_KROW;
    u32x4 kreg[8], vreg[8]; bf16x8 qn[4];
#define ATT_DECODE(pair_) const int it = 2 * (pair_) + half, b = it / 320, rem = it - 320 * b, hq = rem >> 4, j = rem & 15; \
        const int jj = hq - 8, g = hq < 8 ? 0 : (jj >> 2), slot = jj & 3, kidx = hq < 8 ? (hq >> 2) : 2 + jj, dil = 1 << (2 * g)
#define ATT_LOAD(pair_) do { ATT_DECODE(pair_); const int krow0 = 128 * j - 128; \
        const bf16* Kg = KP + ((size_t)(b * 14 + kidx) * 2048) * 64; const bf16* Vg = VP + ((size_t)(b * 14 + kidx) * 2048) * 64; \
        const bf16* Qg = QP + ((size_t)(b * 20 + hq) * 2048 + 128 * j + 32 * w + r32) * 64 + hi * 8; \
        _Pragma("unroll") for (int d0 = 0; d0 < 4; ++d0) qn[d0] = *(const bf16x8*)(Qg + d0 * 16); \
        _Pragma("unroll") for (int c = 0; c < 8; ++c) { const int ch = htid + 256 * c; int grow = krow0 + (ch >> 3); grow = grow < 0 ? grow + 128 : grow; const size_t off = (size_t)grow * 64 + (ch & 7) * 8; \
            kreg[c] = *(const u32x4*)(Kg + off); vreg[c] = *(const u32x4*)(Vg + off); } } while (0)
    if ((int)blockIdx.x < 2560) ATT_LOAD((int)blockIdx.x);
    for (int pair = blockIdx.x; pair < 2560; pair += gridDim.x) {
        ATT_DECODE(pair);
        const int nblk = 16 >> (2 * g), blk = j & (nblk - 1), rres = j >> (4 - 2 * g); const bool hasprev = blk != 0;
        const float sd = exp2f(-0.4f * (float)(hq + 1)) * LOG2E * (float)dil;
        __syncthreads();
#pragma unroll
        for (int c = 0; c < 8; ++c) { const int ch = htid + 256 * c, row = ch >> 3, cc = ch & 7; *(LAS u32x4*)(Kl + row * ATT_KROW + cc * 16) = kreg[c]; *(LAS u32x4*)(Vl + row * ATT_KROW + cc * 16) = vreg[c]; }
        bf16x8 qf[4];
#pragma unroll
        for (int d0 = 0; d0 < 4; ++d0) qf[d0] = qn[d0];
        __syncthreads();
        if (pair + (int)gridDim.x < 2560) ATT_LOAD(pair + (int)gridDim.x);
        float sink2 = 0.f, mx = -1e30f, lsum = 0.f;
        if (hq < 8) { sink2 = sinks[hq] * LOG2E; mx = sink2; lsum = hi == 0 ? 1.f : 0.f; }
        f32x16 o[2];
        o[0] = (f32x16){0.f, 0.f, 0.f, 0.f, 0.f, 0.f, 0.f, 0.f, 0.f, 0.f, 0.f, 0.f, 0.f, 0.f, 0.f, 0.f}; o[1] = o[0];
        const LAS unsigned char* vb = Vl + (32 * w + 4 * hi + ((lane & 15) >> 2)) * ATT_KROW + (16 * ((lane >> 4) & 1) + 4 * (lane & 3)) * 2;
#pragma unroll
        for (int kbi = 0; kbi < 5; ++kbi) { const int kb = 4 - kbi;
            f32x16 S = (f32x16){0.f, 0.f, 0.f, 0.f, 0.f, 0.f, 0.f, 0.f, 0.f, 0.f, 0.f, 0.f, 0.f, 0.f, 0.f, 0.f};
            const LAS unsigned char* kp = Kl + (32 * w + 32 * kb + r32) * ATT_KROW + hi * 16;
#pragma unroll
            for (int d0 = 0; d0 < 4; ++d0) { const bf16x8 kf = *(const LAS bf16x8*)(kp + d0 * 32); S = __builtin_amdgcn_mfma_f32_32x32x16_bf16(kf, qf[d0], S, 0, 0, 0); }
            float tmax = -1e30f;
#pragma unroll
            for (int r = 0; r < 16; ++r) { const int c = crow_c(r) + 4 * hi; const int dist = r32 + 128 - 32 * kb - c;
                float v = S[r] - sd * (float)dist;
                if (kb == 0) v = dist <= 128 ? v : -1e30f;
                if (kb == 4) v = dist >= 0 ? v : -1e30f;
                if (kb < 4) { const int ki = 32 * w + 32 * kb + c; v = (hasprev || ki >= 128) ? v : -1e30f; }
                S[r] = v; tmax = fmaxf(tmax, v); }
            tmax = fmaxf(tmax, __shfl_xor(tmax, 32));
            const float mnew = fmaxf(mx, tmax);
            if (kbi > 0 && __builtin_amdgcn_ballot_w64(mnew > mx) != 0ull) { const float al = __builtin_amdgcn_exp2f(mx - mnew); lsum *= al;
#pragma unroll
                for (int r = 0; r < 16; ++r) { o[0][r] *= al; o[1][r] *= al; } }
            else if (kbi == 0) lsum *= __builtin_amdgcn_exp2f(mx - mnew);
            mx = mnew;
#pragma unroll
            for (int r = 0; r < 16; ++r) { const float p = __builtin_amdgcn_exp2f(S[r] - mx); S[r] = p; lsum += p; }
#pragma unroll
            for (int kk = 0; kk < 2; ++kk) {
                u32x4 pw; pw.x = cvt_pk_bf16(S[8 * kk + 0], S[8 * kk + 1]); pw.y = cvt_pk_bf16(S[8 * kk + 2], S[8 * kk + 3]); pw.z = cvt_pk_bf16(S[8 * kk + 4], S[8 * kk + 5]); pw.w = cvt_pk_bf16(S[8 * kk + 6], S[8 * kk + 7]);
                const bf16x8 pf = __builtin_bit_cast(bf16x8, pw);
#pragma unroll
                for (int dh = 0; dh < 2; ++dh) {
                    const LAS unsigned char* vp = vb + (32 * kb + 16 * kk) * ATT_KROW + dh * 64;
                    const s16x4 lo = vtr(vp), hh = vtr(vp + 8 * ATT_KROW);
                    const bf16x8 vf = {lo[0], lo[1], lo[2], lo[3], hh[0], hh[1], hh[2], hh[3]};
                    o[dh] = __builtin_amdgcn_mfma_f32_32x32x16_bf16(vf, pf, o[dh], 0, 0, 0);
                }
            }
        }
        lsum += __shfl_xor(lsum, 32);
        const float inv = __builtin_amdgcn_rcpf(lsum);
        const int sq = (blk * 128 + 32 * w + r32) * dil + rres; const size_t row = (size_t)b * 2048 + sq;
        bf16* dst = (hq < 8) ? OA + row * 768 + hq * 64 : OB3 + ((size_t)g * MP + row) * 256 + slot * 64;
#pragma unroll
        for (int dh = 0; dh < 2; ++dh)
#pragma unroll
            for (int c = 0; c < 4; ++c) { u32x2 wv; wv.x = cvt_pk_bf16(o[dh][4 * c] * inv, o[dh][4 * c + 1] * inv); wv.y = cvt_pk_bf16(o[dh][4 * c + 2] * inv, o[dh][4 * c + 3] * inv);
                *(u32x2*)(dst + 32 * dh + 8 * c + 4 * hi) = wv; }
        if (hq >= 8 && hi == 0) LSE3[((size_t)g * MP + row) * 4 + slot] = (mx + __builtin_amdgcn_logf(lsum)) * LN2;
    }
#undef ATT_LOAD
#undef ATT_DECODE
    __syncthreads();
}

__device__ __forceinline__ void phase_merge(KParams P, const int wave_sg) {
    unsigned char* ws = P->ws;
    const bf16* OB3 = (const bf16*)(ws + WS_OB3); const float* LSE3 = (const float*)(ws + WS_LSE3); bf16* OBM = (bf16*)(ws + WS_XAB) + 512;
    const long gtid = (long)blockIdx.x * 512 + TID_NOW(wave_sg), gthreads = (long)gridDim.x * 512;
    for (long i = gtid; i < (long)MV * 32; i += gthreads) {
        const long row = i >> 5; const int ch = (int)(i & 31), slot = ch >> 3;
        float l[3], mx = -1e30f;
#pragma unroll
        for (int g = 0; g < 3; ++g) { l[g] = LSE3[((size_t)g * MP + row) * 4 + slot]; mx = fmaxf(mx, l[g]); }
        float wsum = 0.f;
#pragma unroll
        for (int g = 0; g < 3; ++g) { l[g] = __builtin_amdgcn_exp2f((l[g] - mx) * LOG2E); wsum += l[g]; }
        const float inv = __builtin_amdgcn_rcpf(wsum);
        float a[8] = {0.f, 0.f, 0.f, 0.f, 0.f, 0.f, 0.f, 0.f};
#pragma unroll
        for (int g = 0; g < 3; ++g) { const u32x4 v = *(const u32x4*)(OB3 + ((size_t)g * MP + row) * 256 + ch * 8); const float wg = l[g] * inv;
            a[0] += wg * bf2f(v.x & 0xffff); a[1] += wg * bf2f(v.x >> 16); a[2] += wg * bf2f(v.y & 0xffff); a[3] += wg * bf2f(v.y >> 16);
            a[4] += wg * bf2f(v.z & 0xffff); a[5] += wg * bf2f(v.z >> 16); a[6] += wg * bf2f(v.w & 0xffff); a[7] += wg * bf2f(v.w >> 16); }
        u32x4 o; o.x = cvt_pk_bf16(a[0], a[1]); o.y = cvt_pk_bf16(a[2], a[3]); o.z = cvt_pk_bf16(a[4], a[5]); o.w = cvt_pk_bf16(a[6], a[7]);
        *(u32x4*)(OBM + row * 768 + ch * 8) = o;
    }
}

#define GEMM_PHASE(EPI, A_, B_, N_, K_, E_) do { pg8::Gemm g_{(const bf16*)(A_), (const bf16*)(B_), MP, (N_), (K_)}; pg8::SplitOrder S_; S_.init((N_), (K_), (int)gridDim.x, (int)blockIdx.x, 1, nullptr, nullptr); \
    pg8::gemm_phase<std::remove_reference_t<decltype(E_)>, pg8::SplitOrder, true, true>(lds, g_, S_, E_, wave_sg); } while (0)
#define GEMM_PHASE_BG(EPI, A_, B_, N_, K_, E_, BG_, SPLIT_, ACCI_) do { pg8::Gemm g_{(const bf16*)(A_), (const bf16*)(B_), MP, (N_), (K_)}; pg8::SplitOrder S_; \
    S_.init((N_), (K_), (int)gridDim.x, (int)blockIdx.x, (SPLIT_), (float*)(ws + WS_ACC) + (size_t)(ACCI_) * ACC_FLOATS, (unsigned*)(ws + WS_ACC + 3 * ACC_FLOATS * 4) + 64 * (ACCI_)); \
    pg8::gemm_phase<std::remove_reference_t<decltype(E_)>, pg8::SplitOrder, true, true, std::remove_reference_t<decltype(BG_)>>(lds, g_, S_, E_, wave_sg, BG_); } while (0)
typedef pg8::BgCopy<2047u * 128u, 2048u * 128u, 128u> BgB3;
typedef pg8::BgCopy<511u * 128u, 512u * 128u, 128u> BgB2;
constexpr unsigned BG_IT = 256u * 512u;
constexpr unsigned B3_TOT = 128u * 2047u * 128u, B2_TOT = 128u * 511u * 128u;
constexpr unsigned B3_C1 = 88u * BG_IT, B3_C2 = B3_C1 + 44u * BG_IT, B3_C3 = B3_C2 + 80u * BG_IT;
constexpr unsigned B2_C1 = 44u * BG_IT;
static_assert(B3_TOT - B3_C3 <= 88u * BG_IT && B2_C1 < B2_TOT, "background copy capacity");

#define LOADP(P_) KParams P_ = kp0; asm volatile("" : "+s"(P_)); unsigned char* const ws = P_->ws; (void)ws
__global__ void __launch_bounds__(512, 2) mega_fwd(Params Parg) {
    extern __shared__ __attribute__((aligned(16))) unsigned char lds_raw[];
    LAS unsigned char* lds = (LAS unsigned char*)lds_raw;
    cg::grid_group grid = cg::this_grid();
    const KParams kp0 = (KParams)__builtin_amdgcn_kernarg_segment_ptr();
    const int wave_sg = __builtin_amdgcn_readfirstlane(threadIdx.x >> 6);
    volatile LAS unsigned* xb_st = (volatile LAS unsigned*)(lds + LDS_BYTES - 16);
    if (TID_NOW(wave_sg) < 4) xb_st[TID_NOW(wave_sg)] = 0u;
    __syncthreads();
    const XcdBarrier xbar = xcd_barrier_post((unsigned*)(kp0->ws + WS_BAR), xb_st, wave_sg);
#define GRID_BAR() xcd_barrier(xbar, wave_sg)
    { LOADP(P); phase_prologue(P, lds, wave_sg); }
    grid.sync();
    const int bgr = (gridDim.x == 256) ? 1 : 0;
    { LOADP(P); { EpiSwiGLU E{(bf16*)(ws + WS_H), (const float*)(ws + WS_SS1)}; BgB3 bg{(const f32x4*)P->in[5], (f32x4*)(P->out + O_B3S), (f32x4*)(ws + WS_DUMP), 0u, B3_C1, 11 * bgr};
        GEMM_PHASE_BG(EpiSwiGLU, ws + WS_XB, ws + WS_W1GU, 2 * DFF, DM, E, bg, 1, 0); }
      if (bgr) { idle_copy(P, 129 * 22, 0u, CP_S1, wave_sg); idle_copy(P, 129 * 22, CP_S1 + B2_C1, CP_S2, wave_sg); } }
    GRID_BAR();
    { LOADP(P); { EpiRes<false, false> E{P->in[0], P->in[1], nullptr, nullptr, (bf16*)(ws + WS_X1B), (float*)(ws + WS_SS2), 0.5f}; BgB3 bg{(const f32x4*)P->in[5], (f32x4*)(P->out + O_B3S), (f32x4*)(ws + WS_DUMP), B3_C1, B3_C2, 2 * bgr};
        GEMM_PHASE_BG(0, ws + WS_H, ws + WS_W1D, DM, DFF, E, bg, 11, 0); } }
    GRID_BAR();
    { LOADP(P); { EpiQKV E{(const float*)(ws + WS_SS2), ws, (bf16*)(ws + WS_G), P->out, (const float*)(ws + WS_GT)}; BgB3 bg{(const f32x4*)P->in[5], (f32x4*)(P->out + O_B3S), (f32x4*)(ws + WS_DUMP), B3_C2, B3_C3, 10 * bgr};
        GEMM_PHASE_BG(EpiQKV, ws + WS_X1B, ws + WS_WIN, INW, DM, E, bg, 1, 0); } }
    GRID_BAR();
    { LOADP(P); phase_attention(P, lds, wave_sg); }
    GRID_BAR();
    { LOADP(P); phase_merge(P, wave_sg); }
    GRID_BAR();
    { LOADP(P); EpiUp E{(const bf16*)(ws + WS_G), (bf16*)(ws + WS_MIXB)}; GEMM_PHASE(EpiUp, ws + WS_XAB, ws + WS_WUA, DM, 768, E); }
    GRID_BAR();
    { LOADP(P); { EpiRes<true, false> E{nullptr, nullptr, (const bf16*)(ws + WS_X1B), nullptr, (bf16*)(ws + WS_X2B), (float*)(ws + WS_SS3), 1.0f}; pg8::BgNone bg; GEMM_PHASE_BG(0, ws + WS_MIXB, ws + WS_WO, DM, DM, E, bg, 4, 2); } }
    GRID_BAR();
    { LOADP(P); { EpiSwiGLU E{(bf16*)(ws + WS_H), (const float*)(ws + WS_SS3)}; BgB3 bg{(const f32x4*)P->in[5], (f32x4*)(P->out + O_B3S), (f32x4*)(ws + WS_DUMP), B3_C3, B3_TOT, 11 * bgr};
        GEMM_PHASE_BG(EpiSwiGLU, ws + WS_X2B, ws + WS_W2GU, 2 * DFF, DM, E, bg, 1, 0); } }
    GRID_BAR();
    { LOADP(P); { EpiRes<true, true> E{nullptr, nullptr, (const bf16*)(ws + WS_X2B), P->out, nullptr, nullptr, 0.5f}; BgB2 bg{(const f32x4*)P->in[4], (f32x4*)(P->out + O_B2S), (f32x4*)(ws + WS_DUMP), 0u, B2_C1, 2 * bgr};
        GEMM_PHASE_BG(0, ws + WS_H, ws + WS_W2D, DM, DFF, E, bg, 11, 1); } }
}

extern "C" void kernel_launch(void* const* d_in, const int* in_sizes, int n_in, void* d_out, int out_size, void* d_ws, size_t ws_size, hipStream_t stream) {
    static int grid = 0;
    if (grid == 0) {
        if (n_in != 24 || ws_size < WS_END) { fprintf(stderr, "kernel_launch: unexpected n_in %d / ws_size %zu\n", n_in, ws_size); grid = -1; return; }
        int dev = 0, cus = 0, per_cu = 0;
        hipGetDevice(&dev); hipDeviceGetAttribute(&cus, hipDeviceAttributeMultiprocessorCount, dev);
        if (hipFuncSetAttribute((const void*)mega_fwd, hipFuncAttributeMaxDynamicSharedMemorySize, LDS_BYTES) != hipSuccess) { fprintf(stderr, "kernel_launch: hipFuncSetAttribute failed\n"); grid = -1; return; }
        if (hipOccupancyMaxActiveBlocksPerMultiprocessor(&per_cu, (const void*)mega_fwd, 512, LDS_BYTES) != hipSuccess || per_cu < 1) { fprintf(stderr, "kernel_launch: occupancy query says %d\n", per_cu); per_cu = 1; }
        (void)hipGetLastError();
        grid = cus * per_cu;
        fprintf(stderr, "kernel_launch: grid %d (cus %d x %d)\n", grid, cus, per_cu);
    }
    if (grid < 0) return;
    if (hipMemsetAsync((char*)d_ws + WS_BAR, 0, XCD_BAR_WORDS * 4, stream) != hipSuccess) { fprintf(stderr, "kernel_launch: hipMemsetAsync of the barrier words failed\n"); return; }
    Params p{};
    for (int i = 0; i < 24; ++i) p.in[i] = (const float*)d_in[i];
    p.out = (float*)d_out; p.ws = (unsigned char*)d_ws;
    void* args[] = {&p};
    hipError_t e = hipLaunchCooperativeKernel((const void*)mega_fwd, dim3(grid), dim3(512), args, LDS_BYTES, stream);
    if (e != hipSuccess) fprintf(stderr, "cooperative launch failed: %s (grid %d)\n", hipGetErrorString(e), grid);
}
```

```cpp
#include <hip/hip_runtime.h>
#include <hip/hip_cooperative_groups.h>
#include <cstdio>
#include <cstdint>
#include <type_traits>
namespace cg = cooperative_groups;
namespace pg8 {
#define PG8_LAS __attribute__((address_space(3)))
typedef unsigned short bf16_t;
typedef short bf16x8 __attribute__((ext_vector_type(8)));
typedef float f32x4 __attribute__((ext_vector_type(4)));
typedef unsigned u32x4 __attribute__((ext_vector_type(4)));
constexpr int BM = 256, BK = 64, HALF = 128, HTB = HALF * BK * 2  , STAGE_BYTES = 8 * HTB, NXCD = 8, WGM = 8;

__host__ __device__ __forceinline__ int lds_byte(int r, int c) { const int st = (r >> 4) * 2 + (c >> 5), rr = r & 15, cc = c & 31, ob = rr * 64 + cc * 2; return st * 1024 + (ob ^ (((ob >> 9) & 1) << 5)); }
__host__ __device__ __forceinline__ void stage_rc(int b, int& R, int& C) { const int st = b / 1024, sb = b % 1024, swz = sb ^ (((sb >> 9) & 1) << 5); R = (st >> 1) * 16 + swz / 64; C = (st & 1) * 32 + (swz % 64) / 2; }
__host__ __device__ __forceinline__ int perm32(int rho) { const int n = rho >> 4, i = rho & 15; return 8 * (i >> 2) + 4 * n + (i & 3); }

struct Unit { int pm, pn, kt0, nt, split; };
struct Gemm { const bf16_t* A; const bf16_t* Bt; int M, N, K; };

struct StaticOrder {
    int nM, nN, nwg, G, c;
    __host__ __device__ void init(int M, int N, int G_, int c_) { nM = M / BM; nN = N / BM; nwg = nM * nN; G = G_; c = c_; }
    __host__ __device__ bool next(int i, Unit& u) const {
        const long L = (long)i * G + c; if (L >= nwg) return false;
        int wgid = (int)L; { const int q = nwg / NXCD, r = nwg % NXCD, xcd = wgid % NXCD, off = wgid / NXCD; wgid = (xcd < r ? xcd * (q + 1) : r * (q + 1) + (xcd - r) * q) + off; }
        const int nig = WGM * nN, gid = wgid / nig, fm = gid * WGM, gsz = (nM - fm) < WGM ? (nM - fm) : WGM;
        u.pm = fm + ((wgid % nig) % gsz); u.pn = (wgid % nig) / gsz; u.kt0 = 0; u.nt = ntK; u.split = 1; return true;
    }
    __device__ __forceinline__ void a_ready(const Unit&) const {}
    __device__ __forceinline__ void done(const Unit&) const {}
    int ntK; float* acc_buf; unsigned* cnt;
};
struct SplitOrder {
    StaticOrder so; int nmain, ntot, S, ntK; float* acc_buf; unsigned* cnt;
    __host__ __device__ void init(int N, int K, int G_, int c_, int S_, float* ab, unsigned* cn) { so.init(128 * BM, N, G_, c_); so.ntK = K / BK; nmain = so.nwg; S = S_; ntK = K / BK; ntot = nmain + so.nN * S; acc_buf = ab; cnt = cn; }
    __host__ __device__ __forceinline__ bool next(int i, Unit& u) const {
        const long L = (long)i * so.G + so.c; if (L >= ntot) return false;
        int pm, pn, kt0 = 0, n = ntK, sp = 1;
        if (L < nmain) {
            int wgid = (int)L; { const int nwg = nmain, q = nwg / NXCD, r = nwg % NXCD, xcd = wgid % NXCD, off = wgid / NXCD; wgid = (xcd < r ? xcd * (q + 1) : r * (q + 1) + (xcd - r) * q) + off; }
            const int nig = WGM * so.nN, gid = wgid / nig, fm = gid * WGM, gsz = (128 - fm) < WGM ? (128 - fm) : WGM;
            pm = fm + ((wgid % nig) % gsz); pn = (wgid % nig) / gsz;
        } else { const int e = (int)L - nmain; pm = 128; pn = e / S; n = ntK / S; kt0 = (e - pn * S) * n; sp = S; }
        u.pm = pm; u.pn = pn; u.kt0 = kt0; u.nt = n; u.split = sp; return true;
    }
    __device__ __forceinline__ void a_ready(const Unit&) const {}
    __device__ __forceinline__ void done(const Unit&) const {}
};

__device__ __forceinline__ unsigned cvt_pk_bf16(float lo, float hi) { unsigned r; asm volatile("v_cvt_pk_bf16_f32 %0, %1, %2" : "=v"(r) : "v"(lo), "v"(hi)); return r; }
typedef float f32x2 __attribute__((ext_vector_type(2)));
struct BgNone { static constexpr unsigned PER = 0; };
template <unsigned PER_, unsigned LR4_, unsigned R4_> struct BgCopy { static constexpr unsigned PER = PER_, LR4 = LR4_, R4 = R4_; const f32x4* src; f32x4* dst; f32x4* dump; unsigned lo, hi; int rounds; };
template <class Epi, class Sched, bool ALIGN_EPI = false, bool SP2 = false, class Bg = BgNone>
__device__ __forceinline__ void gemm_phase(PG8_LAS unsigned char* lds, const Gemm g, const Sched& S, const Epi& E, const int wave_sg, const Bg& bg = Bg()) {
    int tid_; asm volatile("v_mbcnt_lo_u32_b32 %0, -1, 0\n\tv_mbcnt_hi_u32_b32 %0, -1, %0\n\tv_lshl_or_b32 %0, %1, 6, %0" : "=&v"(tid_) : "s"(wave_sg));
    const int tid = tid_, wid = __builtin_amdgcn_readfirstlane(tid >> 6), lane = tid & 63, wr = wid >> 2, wc = wid & 3, fr = lane & 15, fq = lane >> 4;
    const int K = g.K, nt = K / BK;
    unsigned voffA[2], voffB[2];
#pragma unroll
    for (int i = 0; i < 2; ++i) { int R, C; stage_rc(tid * 16 + i * 8192, R, C); const int Rb = Epi::PERM ? ((R & ~31) + perm32(R & 31)) : R;
        voffA[i] = (unsigned)(R * K + C) * 2u; voffB[i] = (unsigned)(Rb * K + C) * 2u; }
    const size_t kstep = (size_t)(BK * 2);
    const size_t hstep = (size_t)HALF * K * 2;
    const size_t tstep = 2 * hstep;
    const unsigned ldsw = (unsigned)wid * 1024u;
    const int aoff = lds_byte(wr * 64 + fr, fq * 8), boff = lds_byte(wc * 32 + fr, fq * 8);
#define PG8_SA(b, h) (((b) * 2 + (h)) * HTB)
#define PG8_SB(b, h) ((4 + (b) * 2 + (h)) * HTB)
#define PG8_STAGE(bufoff, gbase, voff) do { _Pragma("unroll") for (int _i = 0; _i < 2; ++_i) \
        __builtin_amdgcn_global_load_lds((const unsigned*)((const char*)(gbase) + (voff)[_i]), (PG8_LAS unsigned*)(lds + (bufoff) + ldsw + _i * 8192), 16, 0, 0); } while (0)
#define PG8_LDA(dst, b, h) do { _Pragma("unroll") for (int m = 0; m < 4; ++m) _Pragma("unroll") for (int k = 0; k < 2; ++k) dst[m][k] = *(const PG8_LAS bf16x8*)(lds + PG8_SA(b, h) + aoff + m * 2048 + k * 1024); } while (0)
#define PG8_LDB(dst, b, h) do { _Pragma("unroll") for (int n = 0; n < 2; ++n) _Pragma("unroll") for (int k = 0; k < 2; ++k) dst[n][k] = *(const PG8_LAS bf16x8*)(lds + PG8_SB(b, h) + boff + n * 2048 + k * 1024); } while (0)
#define PG8_MMA(ai, bj, At, Bt) do { __builtin_amdgcn_s_setprio(1); _Pragma("unroll") for (int m = 0; m < 4; ++m) _Pragma("unroll") for (int n = 0; n < 2; ++n) _Pragma("unroll") for (int k = 0; k < 2; ++k) \
        acc[ai][bj][m][n] = __builtin_amdgcn_mfma_f32_16x16x32_bf16(Bt[n][k], At[m][k], acc[ai][bj][m][n], 0, 0, 0); __builtin_amdgcn_s_setprio(0); } while (0)
#define PG8_WAIT_V(n) asm volatile("s_waitcnt vmcnt(" #n ")" ::: "memory")
#define PG8_WAIT_L(n) asm volatile("s_waitcnt lgkmcnt(" #n ")" ::: "memory")
#define PG8_BAR __builtin_amdgcn_s_barrier()
#define PG8_SCHED __builtin_amdgcn_sched_barrier(0)
    Unit cur, nxt; int ui = 0;
    f32x4 bgdata = {0.f, 0.f, 0.f, 0.f}; f32x4* bgdst = nullptr;
    if constexpr (Bg::PER != 0) bgdst = bg.dump + (size_t)blockIdx.x * 512 + tid;
    if (!S.next(0, cur)) return;
    f32x4 acc[2][2][4][2];
#pragma unroll
    for (int a = 0; a < 2; ++a)
#pragma unroll
        for (int b = 0; b < 2; ++b)
#pragma unroll
            for (int m = 0; m < 4; ++m)
#pragma unroll
                for (int n = 0; n < 2; ++n) acc[a][b][m][n] = (f32x4){0.f, 0.f, 0.f, 0.f};
    bf16x8 At[4][2], B0[2][2], B1[2][2];
    const char* cA = (const char*)g.A + (size_t)cur.pm * tstep + (size_t)cur.kt0 * kstep; const char* cB = (const char*)g.Bt + (size_t)cur.pn * tstep + (size_t)cur.kt0 * kstep;
    S.a_ready(cur);
    if constexpr (SP2) {
        PG8_STAGE(PG8_SB(0, 0), cB, voffB); PG8_STAGE(PG8_SB(0, 1), cB + hstep, voffB); PG8_STAGE(PG8_SA(0, 0), cA, voffA); PG8_STAGE(PG8_SA(0, 1), cA + hstep, voffA);
        if (wr == 1) PG8_BAR;
        PG8_WAIT_V(2); PG8_BAR;
        PG8_STAGE(PG8_SB(1, 0), cB + kstep, voffB); PG8_STAGE(PG8_SA(1, 0), cA + kstep, voffA); PG8_STAGE(PG8_SB(1, 1), cB + hstep + kstep, voffB);
        PG8_WAIT_V(6); PG8_BAR;
    } else {
        PG8_STAGE(PG8_SB(0, 0), cB, voffB); PG8_STAGE(PG8_SA(0, 0), cA, voffA); PG8_STAGE(PG8_SB(0, 1), cB + hstep, voffB); PG8_STAGE(PG8_SA(0, 1), cA + hstep, voffA);
        if (wr == 1) PG8_BAR;
        PG8_WAIT_V(4); PG8_BAR;
        PG8_STAGE(PG8_SB(1, 0), cB + kstep, voffB); PG8_STAGE(PG8_SA(1, 0), cA + kstep, voffA); PG8_STAGE(PG8_SB(1, 1), cB + hstep + kstep, voffB);
        PG8_WAIT_V(6); PG8_BAR;
    }
    for (;;) {
        const bool has_next = S.next(ui + 1, nxt);
        const char* nA = has_next ? (const char*)g.A + (size_t)nxt.pm * tstep + (size_t)nxt.kt0 * kstep : cA; const char* nB = has_next ? (const char*)g.Bt + (size_t)nxt.pn * tstep + (size_t)nxt.kt0 * kstep : cB;
        const int cnt_ = cur.nt;
        for (int t = 0; t < cnt_; t += 2) {
            if constexpr (Epi::HOOK_T >= 0) { if (t == Epi::HOOK_T) E.hook(acc, cur, wr, wc, fr, fq); }
            const bool last = (t == cnt_ - 2);
            const char* a1 = cA + (size_t)(t + 1) * kstep;
            const char* a2 = last ? nA : cA + (size_t)(t + 2) * kstep; const char* b2 = last ? nB : cB + (size_t)(t + 2) * kstep;
            const char* a3 = a2 + kstep; const char* b3 = b2 + kstep;
            if (last && has_next) S.a_ready(nxt);
            if constexpr (SP2) {
            bool bg_on = false;
            if constexpr (Bg::PER != 0) { bg_on = ui < bg.rounds;
                if (bg_on) {
                    const unsigned idx = bg.lo + (unsigned)((ui * (nt >> 1) + (t >> 1)) * (int)gridDim.x + (int)blockIdx.x) * 512u + (unsigned)tid; const bool ok = idx < bg.hi;
                    const unsigned n = idx / Bg::PER, j = idx - n * Bg::PER; const size_t so = (size_t)n * Bg::LR4 + j;
                    const f32x4* sp = ok ? bg.src + so + Bg::R4 : bg.src; f32x4* nd = ok ? bg.dst + so : bg.dump + (size_t)blockIdx.x * 512 + tid;
                    asm volatile("global_store_dwordx4 %1, %0, off nt\n\tglobal_load_dwordx4 %0, %2, off nt" : "+v"(bgdata) : "v"(bgdst), "v"(sp) : "memory");
                    bgdst = nd; } }
            PG8_LDB(B0, 0, 0); PG8_LDB(B1, 0, 1); PG8_SCHED; PG8_LDA(At, 0, 0); PG8_STAGE(PG8_SA(1, 1), a1 + hstep, voffA);
            if (bg_on) { PG8_WAIT_V(10); } else { PG8_WAIT_V(8); } PG8_WAIT_L(0); PG8_BAR; PG8_MMA(0, 0, At, B0); PG8_MMA(0, 1, At, B1); PG8_BAR; PG8_SCHED;
            PG8_LDA(At, 0, 1); PG8_STAGE(PG8_SB(0, 0), b2, voffB); PG8_STAGE(PG8_SB(0, 1), b2 + hstep, voffB); PG8_STAGE(PG8_SA(0, 0), a2, voffA);
            if (bg_on) { PG8_WAIT_V(10); } else { PG8_WAIT_V(8); } PG8_WAIT_L(0); PG8_BAR; PG8_MMA(1, 0, At, B0); PG8_MMA(1, 1, At, B1); PG8_BAR; PG8_SCHED;
            PG8_LDB(B0, 1, 0); PG8_LDB(B1, 1, 1); PG8_SCHED; PG8_LDA(At, 1, 0); PG8_STAGE(PG8_SA(0, 1), a2 + hstep, voffA);
            PG8_WAIT_V(8); PG8_WAIT_L(0); PG8_BAR; PG8_MMA(0, 0, At, B0); PG8_MMA(0, 1, At, B1); PG8_BAR; PG8_SCHED;
            PG8_LDA(At, 1, 1); PG8_STAGE(PG8_SB(1, 0), b3, voffB); PG8_STAGE(PG8_SB(1, 1), b3 + hstep, voffB); PG8_STAGE(PG8_SA(1, 0), a3, voffA);
            PG8_WAIT_V(8); PG8_WAIT_L(0); PG8_BAR; PG8_MMA(1, 0, At, B0); PG8_MMA(1, 1, At, B1); PG8_BAR; PG8_SCHED;
            } else {
            PG8_LDB(B0, 0, 0); PG8_SCHED; PG8_LDA(At, 0, 0); PG8_STAGE(PG8_SA(1, 1), a1 + hstep, voffA);
            PG8_WAIT_L(8); PG8_BAR; PG8_WAIT_L(0); PG8_MMA(0, 0, At, B0); PG8_BAR; PG8_SCHED;
            PG8_LDB(B1, 0, 1); PG8_STAGE(PG8_SB(0, 0), b2, voffB);
            PG8_BAR; PG8_WAIT_L(0); PG8_MMA(0, 1, At, B1); PG8_BAR;
            PG8_LDA(At, 0, 1); PG8_STAGE(PG8_SA(0, 0), a2, voffA);
            PG8_BAR; PG8_WAIT_L(0); PG8_MMA(1, 0, At, B0); PG8_BAR; PG8_SCHED;
            PG8_STAGE(PG8_SB(0, 1), b2 + hstep, voffB);
            PG8_WAIT_V(6); PG8_BAR; PG8_MMA(1, 1, At, B1); PG8_BAR;
            PG8_LDB(B0, 1, 0); PG8_SCHED; PG8_LDA(At, 1, 0); PG8_STAGE(PG8_SA(0, 1), a2 + hstep, voffA);
            PG8_WAIT_L(8); PG8_BAR; PG8_WAIT_L(0); PG8_MMA(0, 0, At, B0); PG8_BAR; PG8_SCHED;
            PG8_LDB(B1, 1, 1); PG8_STAGE(PG8_SB(1, 0), b3, voffB);
            PG8_BAR; PG8_WAIT_L(0); PG8_MMA(0, 1, At, B1); PG8_BAR;
            PG8_LDA(At, 1, 1); PG8_STAGE(PG8_SA(1, 0), a3, voffA);
            PG8_BAR; PG8_WAIT_L(0); PG8_MMA(1, 0, At, B0); PG8_BAR; PG8_SCHED;
            PG8_STAGE(PG8_SB(1, 1), b3 + hstep, voffB);
            PG8_WAIT_V(6); PG8_BAR; PG8_MMA(1, 1, At, B1); PG8_BAR;
            }
        }
        if constexpr (ALIGN_EPI) { if (wr == 0) PG8_BAR; }
        if (cur.split > 1) {
            float* ab = S.acc_buf + (size_t)cur.pn * (64 * 512) + tid;
#pragma unroll
            for (int m = 0; m < 4; ++m)
#pragma unroll
                for (int bj = 0; bj < 2; ++bj)
#pragma unroll
                    for (int n = 0; n < 2; ++n)
#pragma unroll
                        for (int c = 0; c < 4; ++c) unsafeAtomicAdd(ab + (((m * 2 + bj) * 2 + n) * 4 + c) * 512, acc[0][bj][m][n][c]);
            __threadfence();
            PG8_LAS unsigned* flag = (PG8_LAS unsigned*)(lds + STAGE_BYTES);
            PG8_BAR;
            if (tid == 0) { const unsigned old = __hip_atomic_fetch_add(S.cnt + cur.pn, 1u, __ATOMIC_ACQ_REL, __HIP_MEMORY_SCOPE_AGENT); *flag = (old == (unsigned)cur.split - 1u) ? 1u : 0u; }
            asm volatile("s_waitcnt lgkmcnt(0)" ::: "memory"); PG8_BAR; asm volatile("" ::: "memory");
            const bool lastone = *flag != 0u;
            asm volatile("s_waitcnt lgkmcnt(0)" ::: "memory"); PG8_BAR;
            if (lastone) { __threadfence();
#pragma unroll
                for (int m = 0; m < 4; ++m)
#pragma unroll
                    for (int bj = 0; bj < 2; ++bj)
#pragma unroll
                        for (int n = 0; n < 2; ++n) {
#pragma unroll
                            for (int c = 0; c < 4; ++c) acc[0][bj][m][n][c] = __hip_atomic_load(ab + (((m * 2 + bj) * 2 + n) * 4 + c) * 512, __ATOMIC_RELAXED, __HIP_MEMORY_SCOPE_AGENT);
                            acc[1][bj][m][n] = (f32x4){0.f, 0.f, 0.f, 0.f}; }
                E(acc, cur, wr, wc, fr, fq); }
        } else
        if constexpr (!Epi::AFTER_DRAIN) { E(acc, cur, wr, wc, fr, fq); S.done(cur); }
        if (!has_next) break;
#pragma unroll
        for (int a = 0; a < 2; ++a)
#pragma unroll
            for (int b = 0; b < 2; ++b)
#pragma unroll
                for (int m = 0; m < 4; ++m)
#pragma unroll
                    for (int n = 0; n < 2; ++n) acc[a][b][m][n] = (f32x4){0.f, 0.f, 0.f, 0.f};
        cur = nxt; cA = nA; cB = nB; ++ui;
        if constexpr (ALIGN_EPI) { if (wr == 1) PG8_BAR; }
    }
    if constexpr (Bg::PER != 0) { if (bg.rounds > 0) asm volatile("global_store_dwordx4 %1, %0, off nt" :: "v"(bgdata), "v"(bgdst) : "memory"); }
    PG8_WAIT_V(0);
    if constexpr (!ALIGN_EPI) { if (wr == 0) PG8_BAR; }
    PG8_BAR;
    if constexpr (Epi::AFTER_DRAIN) { E.fused(acc, cur, wr, wc, fr, fq, lds, wid, lane); S.done(cur); }
#undef PG8_SA
#undef PG8_SB
#undef PG8_STAGE
#undef PG8_LDA
#undef PG8_LDB
#undef PG8_MMA
#undef PG8_WAIT_V
#undef PG8_WAIT_L
#undef PG8_BAR
#undef PG8_SCHED
}
}

#ifndef PG8_SP2
#define PG8_SP2 true
#endif
#define LAS __attribute__((address_space(3)))
typedef unsigned short bf16;
typedef pg8::f32x4 f32x4;
typedef pg8::u32x4 u32x4;
typedef pg8::bf16x8 bf16x8;
typedef unsigned u32x2 __attribute__((ext_vector_type(2)));
typedef float f32x16 __attribute__((ext_vector_type(16)));
typedef short s16x4 __attribute__((ext_vector_type(4)));
using pg8::cvt_pk_bf16;

constexpr int DM = 1024, DFF = 2816, SEQ = 2048, MPR = 32768, NS = 128, MV = MPR + NS, MP = 33024, INW = 5120;
constexpr float EPS = 1e-6f;
constexpr float LOG2E = 1.4426950408889634f, LN2 = 0.6931471805599453f;
constexpr float QSCALE = 0.125f * LOG2E;
constexpr size_t MiB = 1u << 20;
constexpr size_t WS_SS1 = 0, WS_SS2 = 256 * 1024, WS_SS3 = 512 * 1024, WS_GT = 768 * 1024;
constexpr size_t WS_W1GU = 1 * MiB, WS_W1D = 13 * MiB, WS_WIN = 19 * MiB, WS_WUA = 29 * MiB, WS_WUB = 30 * MiB, WS_WO = 31 * MiB, WS_W2GU = 33 * MiB, WS_W2D = 45 * MiB;
constexpr size_t WS_XB = 52 * MiB, WS_H = 117 * MiB, WS_X1 = 295 * MiB, WS_X1B = 424 * MiB, WS_QP = 489 * MiB, WS_KP = 569 * MiB, WS_VP = 625 * MiB, WS_QS = 681 * MiB;
constexpr size_t WS_G = 682 * MiB, WS_XAB = 912 * MiB, WS_OB3 = 844 * MiB, WS_LSE3 = 893 * MiB, WS_MIXB = 1041 * MiB, WS_X2B = 1106 * MiB, WS_DUMP = 1171 * MiB, WS_ACC = 1174 * MiB, WS_BAR = 1176 * MiB, WS_END = 1177 * MiB;
constexpr size_t ACC_FLOATS = 4 * 64 * 512;
constexpr size_t O_YP = 0, O_YS = 33554432, O_AP = 33685504, O_B1P = 34209792, O_B2P = 35258368, O_B3P = 39452672, O_AS = 56229888, O_B1S = 60424192, O_B2S = 68812800, O_B3S = 102367232;

constexpr int ATT_KROW = 144, ATT_HALF = 2 * 256 * ATT_KROW, ATT_PL = 2 * ATT_HALF;
constexpr int LDS_BYTES = ATT_PL + 8 * 1024;

__device__ __forceinline__ int tid_now_(int wave_sg) { int t; asm volatile("v_mbcnt_lo_u32_b32 %0, -1, 0\n\tv_mbcnt_hi_u32_b32 %0, -1, %0\n\tv_lshl_or_b32 %0, %1, 6, %0" : "=&v"(t) : "s"(wave_sg)); return t; }
#define TID_NOW(wave_sg) tid_now_(wave_sg)
struct Params {
    const float* in[24];
    float* out;
    unsigned char* ws;
};
typedef const __attribute__((address_space(4))) Params* KParams;
#define XB_TMO      128
#define XB_XCNT(j)  (256  + 64 * (j))
#define XB_XSUB(j)  (1280 + 64 * (j))
#define XB_XGEN(j)  (2304 + 64 * (j))
#define XB_TOP      3328
#define XB_TOPGEN   3392
#define XCD_BAR_WORDS 3456
#define XB_SPIN_CAP (1u << 18)

__device__ __forceinline__ unsigned xb_ld(unsigned* p)              { return __hip_atomic_load(p, __ATOMIC_RELAXED, __HIP_MEMORY_SCOPE_AGENT); }
__device__ __forceinline__ unsigned xb_add(unsigned* p, unsigned v) { return __hip_atomic_fetch_add(p, v, __ATOMIC_RELAXED, __HIP_MEMORY_SCOPE_AGENT); }
__device__ __forceinline__ unsigned xb_xcc_id() { return (unsigned)__builtin_amdgcn_s_getreg((3 << 11) | 20) & 0xFu; }
#define XB_SPIN(cond, bar) do { unsigned _sp = 0; while (cond) { __builtin_amdgcn_s_sleep(1); \
    if ((++_sp & 255u) == 0u) { if (xb_ld(&(bar)[XB_TMO])) break; if (_sp > XB_SPIN_CAP) { atomicAdd(&(bar)[XB_TMO], 1u); break; } } } } while (0)

struct XcdBarrier {
    unsigned* bar; unsigned x;
    volatile LAS unsigned* st;
};

__device__ __forceinline__ XcdBarrier xcd_barrier_post(unsigned* bar, volatile LAS unsigned* st, int wave_sg) {
    XcdBarrier b; b.bar = bar; b.x = xb_xcc_id(); b.st = st;
    if (TID_NOW(wave_sg) == 0) (void)xb_add(&bar[XB_XCNT(b.x)], 1u);
    return b;
}
__device__ __forceinline__ void xcd_barrier_complete(unsigned* bar, unsigned x, unsigned& nloc, unsigned& nx) {
    const unsigned G = gridDim.x * gridDim.y * gridDim.z;
    unsigned sum, cnt, mine, sp = 0u;
    for (;;) {
        sum = 0u; cnt = 0u; mine = 0u;
#pragma unroll
        for (unsigned j = 0; j < 16; ++j) { const unsigned c = xb_ld(&bar[XB_XCNT(j)]); sum += c; cnt += (c > 0u) ? 1u : 0u; mine = (j == x) ? c : mine; }
        if (sum == G) break;
        __builtin_amdgcn_s_sleep(1);
        if ((++sp & 255u) == 0u) { if (xb_ld(&bar[XB_TMO])) break; if (sp > XB_SPIN_CAP) { atomicAdd(&bar[XB_TMO], 1u); break; } }
    }
    nloc = mine > 0u ? mine : 1u; nx = cnt > 0u ? cnt : 1u;
}

__device__ __forceinline__ void xcd_barrier(const XcdBarrier& b, int wave_sg) {
    asm volatile("s_waitcnt vmcnt(0)" ::: "memory");
    __syncthreads();
    if (TID_NOW(wave_sg) == 0) {
        unsigned* bar = b.bar;
        __builtin_amdgcn_s_waitcnt(0);
        unsigned nloc = b.st[0], nx = b.st[1];
        if (nloc == 0u) { xcd_barrier_complete(bar, b.x, nloc, nx); b.st[0] = nloc; b.st[1] = nx; }
        const unsigned old = xb_add(&bar[XB_XSUB(b.x)], 1u);
        const unsigned gen = old / nloc;
        if (old + 1u == (gen + 1u) * nloc) {
            __builtin_amdgcn_fence(__ATOMIC_RELEASE, "agent");
            asm volatile("s_waitcnt vmcnt(0)" ::: "memory");
            const unsigned og = xb_add(&bar[XB_TOP], 1u);
            const unsigned tg = og / nx;
            if (og + 1u == (tg + 1u) * nx) xb_add(&bar[XB_TOPGEN], 1u);
            else XB_SPIN(xb_ld(&bar[XB_TOPGEN]) == tg, bar);
            __builtin_amdgcn_fence(__ATOMIC_ACQUIRE, "agent");
            xb_add(&bar[XB_XGEN(b.x)], 1u);
            asm volatile("s_waitcnt vmcnt(0)" ::: "memory");
        } else {
            XB_SPIN(xb_ld(&bar[XB_XGEN(b.x)]) == gen, bar);
            __builtin_amdgcn_fence(__ATOMIC_ACQUIRE, "agent");
            asm volatile("s_waitcnt vmcnt(0)" ::: "memory");
        }
    }
    __syncthreads();
}


__device__ __forceinline__ float wave_sum(float v) {
#pragma unroll
    for (int o = 1; o < 64; o <<= 1) v += __shfl_xor(v, o);
    return v;
}
__device__ __forceinline__ float wave_max(float v) {
#pragma unroll
    for (int o = 1; o < 64; o <<= 1) v = fmaxf(v, __shfl_xor(v, o));
    return v;
}
__device__ __forceinline__ float bf2f(unsigned short b) { return __builtin_bit_cast(float, (unsigned)b << 16); }
__device__ __forceinline__ float sigmoidf_(float x) { return __builtin_amdgcn_rcpf(1.f + __builtin_amdgcn_exp2f(-x * LOG2E)); }

__device__ __forceinline__ void tr_item(const float* __restrict__ W, int ldw, int k0, int ns0, bf16* WT, int K, int nd0, const float* __restrict__ gain, LAS float* scr, int lane) {
#pragma unroll 16
    for (int i = 0; i < 32; ++i) { const int kk = 2 * i + (lane >> 5); float w = W[(size_t)(k0 + kk) * ldw + ns0 + (lane & 31)]; if (gain) w *= gain[k0 + kk]; scr[kk * 33 + (lane & 31)] = w; }
    asm volatile("s_waitcnt lgkmcnt(0)" ::: "memory");
    const int c = lane & 7;
#pragma unroll
    for (int j = 0; j < 4; ++j) { const int n = (lane >> 3) + 8 * j; const LAS float* s = scr + (8 * c) * 33 + n;
        u32x4 o; o.x = cvt_pk_bf16(s[0 * 33], s[1 * 33]); o.y = cvt_pk_bf16(s[2 * 33], s[3 * 33]); o.z = cvt_pk_bf16(s[4 * 33], s[5 * 33]); o.w = cvt_pk_bf16(s[6 * 33], s[7 * 33]);
        *(u32x4*)(WT + (size_t)(nd0 + n) * K + k0 + 8 * c) = o; }
    asm volatile("s_waitcnt lgkmcnt(0)" ::: "memory");
}
template <int L, int R> __device__ __forceinline__ void copy_seg(const float* __restrict__ src, float* __restrict__ dst, unsigned lo, unsigned hi, unsigned t0, unsigned nthr) {
    constexpr unsigned PER = (unsigned)(L - 1) * R / 4, LR4 = (unsigned)L * R / 4, R4 = R / 4;
    const f32x4* s4 = (const f32x4*)src; f32x4* d4 = (f32x4*)dst;
    unsigned i = lo + t0;
    for (; i + 3 * nthr < hi; i += 4 * nthr) {
        f32x4 v[4];
#pragma unroll
        for (int u = 0; u < 4; ++u) { const unsigned ii = i + u * nthr, n = ii / PER, j = ii - n * PER; v[u] = __builtin_nontemporal_load(s4 + (size_t)n * LR4 + R4 + j); }
#pragma unroll
        for (int u = 0; u < 4; ++u) { const unsigned ii = i + u * nthr, n = ii / PER, j = ii - n * PER; __builtin_nontemporal_store(v[u], d4 + (size_t)n * LR4 + j); }
    }
    for (; i < hi; i += nthr) { const unsigned n = i / PER, j = i - n * PER; __builtin_nontemporal_store(__builtin_nontemporal_load(s4 + (size_t)n * LR4 + R4 + j), d4 + (size_t)n * LR4 + j); }
}
constexpr unsigned CP_S0 = 128u * 127 * 64, CP_S1 = CP_S0 + 128u * 127 * 128, CP_S2 = CP_S1 + 128u * 511 * 128, CP_TOT = CP_S2 + 128u * 2047 * 128;
__device__ __forceinline__ void copy_slice(KParams P, unsigned lo, unsigned hi, unsigned t0, unsigned nthr) {
    if (lo < CP_S0 && hi > 0) copy_seg<128, 256>(P->in[2], P->out + O_AS, lo, hi < CP_S0 ? hi : CP_S0, t0, nthr);
    if (lo < CP_S1 && hi > CP_S0) copy_seg<128, 512>(P->in[3], P->out + O_B1S, (lo > CP_S0 ? lo : CP_S0) - CP_S0, (hi < CP_S1 ? hi : CP_S1) - CP_S0, t0, nthr);
    if (lo < CP_S2 && hi > CP_S1) copy_seg<512, 512>(P->in[4], P->out + O_B2S, (lo > CP_S1 ? lo : CP_S1) - CP_S1, (hi < CP_S2 ? hi : CP_S2) - CP_S1, t0, nthr);
    if (lo < CP_TOT && hi > CP_S2) copy_seg<2048, 512>(P->in[5], P->out + O_B3S, (lo > CP_S2 ? lo : CP_S2) - CP_S2, (hi < CP_TOT ? hi : CP_TOT) - CP_S2, t0, nthr);
}
constexpr unsigned cp_cut(double f) { return (unsigned)(f * (double)CP_TOT) & ~3u; }
constexpr unsigned CPC0 = 0, CPC1 = cp_cut(0.15), CPC2 = cp_cut(0.235), CPC3 = cp_cut(0.485), CPC4 = cp_cut(0.571), CPC5 = cp_cut(0.663), CPC6 = cp_cut(0.75), CPC7 = CP_TOT;
__device__ __forceinline__ void idle_copy(KParams P, int nwg, unsigned lo, unsigned hi, const int wave_sg) {
    const int G = gridDim.x, busy = nwg % G; const int tid = TID_NOW(wave_sg);
    if (busy == 0 || (int)blockIdx.x < busy) { if (busy == 0) copy_slice(P, lo, hi, blockIdx.x * 512 + tid, G * 512); return; }
    copy_slice(P, lo, hi, (blockIdx.x - busy) * 512 + tid, (G - busy) * 512);
}
__device__ __forceinline__ void phase_prologue(KParams P, LAS unsigned char* lds, const int wave_sg) {
    const int tid = TID_NOW(wave_sg), lane = tid & 63, wave = wave_sg;
    const int gw = blockIdx.x * 8 + wave, NGW = gridDim.x * 8;
    unsigned char* ws = P->ws;
    LAS float* scr = (LAS float*)(lds + wave * 16384);
    constexpr int I_GU = 16 * 176, I_D = 44 * 32, I_IN = 16 * 160, I_UA = 8 * 32, I_UB = 4 * 32, I_O = 16 * 32;
    constexpr int NITEMS = 2 * I_GU + 2 * I_D + I_IN + I_UA + I_UB + I_O;
    for (int it = gw; it < NITEMS; it += NGW) {
        int r = it;
        if (r < 2 * I_GU) { const int L = r / I_GU; r -= L * I_GU; const int kb = r / 176, nb = r % 176, nd0 = 32 * nb, pn = nd0 >> 8, bj = (nd0 >> 7) & 1, c = nd0 & 127;
            const float* W = P->in[L ? (bj ? 22 : 21) : (bj ? 8 : 7)];
            tr_item(W, DFF, 64 * kb, 128 * pn + c, (bf16*)(ws + (L ? WS_W2GU : WS_W1GU)), DM, nd0, P->in[L ? 20 : 6], scr, lane); continue; }
        r -= 2 * I_GU;
        if (r < 2 * I_D) { const int L = r / I_D; r -= L * I_D; const int kb = r / 32, nb = r % 32;
            tr_item(P->in[L ? 23 : 9], DM, 64 * kb, 32 * nb, (bf16*)(ws + (L ? WS_W2D : WS_W1D)), DFF, 32 * nb, nullptr, scr, lane); continue; }
        r -= 2 * I_D;
        if (r < I_IN) { const int kb = r / 160, nb = r % 160, nd0 = 32 * nb; int ns0 = nd0;
            if (nd0 < 3072) { const int pn = nd0 >> 8, cl = nd0 & 255, bj = cl >> 7, wc = (cl >> 5) & 3; ns0 = 64 * (4 * pn + wc) + 32 * bj; }
            tr_item(P->in[11], INW, 64 * kb, ns0, (bf16*)(ws + WS_WIN), DM, nd0, P->in[10], scr, lane); continue; }
        r -= I_IN;
        if (r < I_UA) { const int kb = r / 32, nb = r % 32; tr_item(P->in[17], DM, 64 * kb, 32 * nb, (bf16*)(ws + WS_WUA), 768, 32 * nb, nullptr, scr, lane); continue; }
        r -= I_UA;
        if (r < I_UB) { const int kb = r / 32, nb = r % 32; tr_item(P->in[18], DM, 64 * kb, 32 * nb, (bf16*)(ws + WS_WUA) + 512, 768, 32 * nb, nullptr, scr, lane); continue; }
        r -= I_UB;
        { const int kb = r / 32, nb = r % 32; tr_item(P->in[19], DM, 64 * kb, 32 * nb, (bf16*)(ws + WS_WO), DM, 32 * nb, nullptr, scr, lane); }
    }
    float* ss1 = (float*)(ws + WS_SS1); float* ss2 = (float*)(ws + WS_SS2); float* ss3 = (float*)(ws + WS_SS3);
    bf16* XB = (bf16*)(ws + WS_XB);
    for (int m = gw; m < MP; m += NGW) {
        unsigned long long* o8 = (unsigned long long*)(XB + (size_t)m * DM) + lane;
        if (m < MV) {
            const float* xr = (m < MPR) ? P->in[0] + (size_t)m * DM : P->in[1] + (size_t)(m - MPR) * DM;
            const f32x4* x4 = (const f32x4*)xr + lane; f32x4 v[4]; float s = 0.f;
#pragma unroll
            for (int j = 0; j < 4; ++j) { v[j] = x4[64 * j]; s += (v[j].x * v[j].x + v[j].y * v[j].y) + (v[j].z * v[j].z + v[j].w * v[j].w); }
            s = wave_sum(s);
#pragma unroll
            for (int j = 0; j < 4; ++j) o8[64 * j] = (unsigned long long)cvt_pk_bf16(v[j].x, v[j].y) | ((unsigned long long)cvt_pk_bf16(v[j].z, v[j].w) << 32);
            if (lane == 0) ss1[m] = s;
        } else {
#pragma unroll
            for (int j = 0; j < 4; ++j) o8[64 * j] = 0ull;
            if (lane == 0) ss1[m] = 0.f;
        }
    }
    const long gtid = (long)blockIdx.x * 512 + tid, gthreads = (long)gridDim.x * 512;
    for (long i = gtid; i < MP; i += gthreads) { ss2[i] = 0.f; ss3[i] = 0.f; }
    for (long i = gtid; i < (long)(3 * ACC_FLOATS + 3 * 64); i += gthreads) ((float*)(ws + WS_ACC))[i] = 0.f;
    if (blockIdx.x == 0 && tid < 320) { float* GT = (float*)(ws + WS_GT); const int r = tid >> 6, d = tid & 63;
        float v = 1.f; if (r == 0) v = P->in[12][d] * QSCALE; else if (r == 1) v = P->in[13][d]; else if (r == 2) v = P->in[14][d] * QSCALE; else if (r == 3) v = P->in[15][d];
        GT[tid] = v; }
    if (gridDim.x != 256) copy_slice(P, 0u, CP_TOT, (unsigned)gtid, (unsigned)gthreads);
}

struct EpiSwiGLU {
    static constexpr bool PERM = true, AFTER_DRAIN = false; static constexpr int HOOK_T = -1;
    bf16* H; const float* ss;
    __device__ __forceinline__ void operator()(const f32x4 (&acc)[2][2][4][2], const pg8::Unit& u, int wr, int wc, int fr, int fq) const {
        const int row0 = u.pm * 256 + wr * 64 + fr, col0 = u.pn * 128 + wc * 32 + 8 * fq;
#pragma unroll
        for (int ai = 0; ai < 2; ++ai)
#pragma unroll
            for (int m = 0; m < 4; ++m) { const int row = row0 + ai * 128 + m * 16; const float rs = __builtin_amdgcn_rsqf(ss[row] * (1.f / DM) + EPS);
                float h[8];
#pragma unroll
                for (int n = 0; n < 2; ++n)
#pragma unroll
                    for (int j = 0; j < 4; ++j) { const float g = acc[ai][0][m][n][j] * rs, up = acc[ai][1][m][n][j] * rs; h[4 * n + j] = g * sigmoidf_(g) * up; }
                u32x4 w; w.x = cvt_pk_bf16(h[0], h[1]); w.y = cvt_pk_bf16(h[2], h[3]); w.z = cvt_pk_bf16(h[4], h[5]); w.w = cvt_pk_bf16(h[6], h[7]);
                *(u32x4*)(H + (size_t)row * DFF + col0) = w; }
    }
};
template <bool RESB, bool OUTF> struct EpiRes {
    static constexpr bool PERM = false, AFTER_DRAIN = false; static constexpr int HOOK_T = -1;
    const float* res_p; const float* res_s; const bf16* resb; float* out; bf16* outb; float* ss; float scale;
    __device__ __forceinline__ void operator()(const f32x4 (&acc)[2][2][4][2], const pg8::Unit& u, int wr, int wc, int fr, int fq) const {
        const int row0 = u.pm * 256 + wr * 64 + fr, col0 = u.pn * 256 + wc * 32 + 4 * fq;
#pragma unroll
        for (int ai = 0; ai < 2; ++ai)
#pragma unroll
            for (int m = 0; m < 4; ++m) { const int row = row0 + ai * 128 + m * 16;
                if (row < MV) {
                    const float* rp = (row < MPR) ? res_p + (size_t)row * DM : res_s + (size_t)(row - MPR) * DM;
                    float s = 0.f;
#pragma unroll
                    for (int bj = 0; bj < 2; ++bj)
#pragma unroll
                        for (int n = 0; n < 2; ++n) { const int col = col0 + bj * 128 + n * 16; f32x4 r;
                            if (RESB) { const u32x2 rw = *(const u32x2*)(resb + (size_t)row * DM + col); r = (f32x4){bf2f(rw.x & 0xffff), bf2f(rw.x >> 16), bf2f(rw.y & 0xffff), bf2f(rw.y >> 16)}; }
                            else r = *(const f32x4*)(rp + col);
                            const f32x4 v = r + acc[ai][bj][m][n] * scale;
                            if (OUTF) *(f32x4*)(out + (size_t)row * DM + col) = v;
                            else { u32x2 w; w.x = cvt_pk_bf16(v[0], v[1]); w.y = cvt_pk_bf16(v[2], v[3]); *(u32x2*)(outb + (size_t)row * DM + col) = w;
                                s += (v[0] * v[0] + v[1] * v[1]) + (v[2] * v[2] + v[3] * v[3]); } }
                    if (!OUTF) { s += __shfl_xor(s, 16); s += __shfl_xor(s, 32); if (fq == 0) atomicAdd(ss + row, s); }
                }
            }
    }
};
struct EpiQKV {
    static constexpr bool PERM = false, AFTER_DRAIN = false; static constexpr int HOOK_T = -1;
    const float* ss; unsigned char* wsb; bf16* G; float* dout; const float* GT;
    __device__ __forceinline__ void operator()(const f32x4 (&acc)[2][2][4][2], const pg8::Unit& u, int wr, int wc, int fr, int fq) const {
        const int row0 = u.pm * 256 + wr * 64 + fr;
        if (u.pn >= 12) {
            const int col0 = (u.pn - 12) * 256 + wc * 32 + 4 * fq;
#pragma unroll
            for (int ai = 0; ai < 2; ++ai)
#pragma unroll
                for (int m = 0; m < 4; ++m) { const int row = row0 + ai * 128 + m * 16; const float rs = __builtin_amdgcn_rsqf(ss[row] * (1.f / DM) + EPS);
#pragma unroll
                    for (int bj = 0; bj < 2; ++bj)
#pragma unroll
                        for (int n = 0; n < 2; ++n) { const f32x4 a = acc[ai][bj][m][n] * rs; u32x2 w; w.x = cvt_pk_bf16(sigmoidf_(a[0]), sigmoidf_(a[1])); w.y = cvt_pk_bf16(sigmoidf_(a[2]), sigmoidf_(a[3]));
                            *(u32x2*)(G + (size_t)row * 2048 + col0 + bj * 128 + n * 16) = w; } }
            return;
        }
        const int hd = 4 * u.pn + wc;
        const bool isA = hd < 12; const int hb = isA ? 0 : hd - 12, t = hb / 12, jj = hb - 12 * t, g = isA ? 0 : (jj >> 2);
        const int kind = isA ? ((hd >= 8) + (hd >= 10)) : t;
        const int hs = isA ? (hd & 1) : (jj & 3), H = isA ? 2 : 4;
        const int idx = isA ? (kind == 0 ? hd : hs) : ((kind == 0 ? 8 : 2) + jj);
        const int sh = 2 * g, dil = 1 << sh, win = 128 << sh;
        const size_t so_p = isA ? O_AP : (O_B1P + (g > 0 ? O_B2P - O_B1P : 0) + (g > 1 ? O_B3P - O_B2P : 0));
        const size_t so_s = isA ? O_AS : (O_B1S + (g > 0 ? O_B2S - O_B1S : 0) + (g > 1 ? O_B3S - O_B2S : 0));
        const int gi = (kind == 2) ? 4 : ((isA ? 0 : 2) + kind);
        const size_t boff = WS_QP + (kind > 0 ? WS_KP - WS_QP : 0) + (kind > 1 ? WS_VP - WS_KP : 0); const int nh = kind == 0 ? 20 : 14;
        f32x4 gv[2][2];
#pragma unroll
        for (int bj = 0; bj < 2; ++bj)
#pragma unroll
            for (int n = 0; n < 2; ++n) gv[bj][n] = *(const f32x4*)(GT + gi * 64 + 32 * bj + 16 * n + 4 * fq);
#pragma unroll
        for (int ai = 0; ai < 2; ++ai)
#pragma unroll
            for (int m = 0; m < 4; ++m) { const int row = row0 + ai * 128 + m * 16; const float rs = __builtin_amdgcn_rsqf(ss[row] * (1.f / DM) + EPS);
                f32x4 v[2][2]; float s = 0.f;
#pragma unroll
                for (int bj = 0; bj < 2; ++bj)
#pragma unroll
                    for (int n = 0; n < 2; ++n) { v[bj][n] = acc[ai][bj][m][n] * rs; s += (v[bj][n][0] * v[bj][n][0] + v[bj][n][1] * v[bj][n][1]) + (v[bj][n][2] * v[bj][n][2] + v[bj][n][3] * v[bj][n][3]); }
                s += __shfl_xor(s, 16); s += __shfl_xor(s, 32);
                const float inv = (kind < 2) ? __builtin_amdgcn_rsqf(s * (1.f / 64.f) + EPS) : 1.f;
#pragma unroll
                for (int bj = 0; bj < 2; ++bj)
#pragma unroll
                    for (int n = 0; n < 2; ++n) v[bj][n] = v[bj][n] * gv[bj][n] * inv;
                if (row < MPR) {
                    const int b = row >> 11, sq = row & 2047, p = ((sq & (dil - 1)) << (11 - sh)) + (sq >> sh);
                    bf16* dst = (bf16*)(wsb + boff) + ((size_t)(b * nh + idx) * 2048 + p) * 64;
#pragma unroll
                    for (int bj = 0; bj < 2; ++bj)
#pragma unroll
                        for (int n = 0; n < 2; ++n) { u32x2 w; w.x = cvt_pk_bf16(v[bj][n][0], v[bj][n][1]); w.y = cvt_pk_bf16(v[bj][n][2], v[bj][n][3]); *(u32x2*)(dst + 32 * bj + 16 * n + 4 * fq) = w; }
                    if (kind > 0 && sq >= 2048 - win) {
                        float* sd = dout + so_p + ((((size_t)b * win + (sq - (2048 - win))) * 2 + (kind - 1)) * H + hs) * 64;
#pragma unroll
                        for (int bj = 0; bj < 2; ++bj)
#pragma unroll
                            for (int n = 0; n < 2; ++n) __builtin_nontemporal_store(v[bj][n], (f32x4*)(sd + 32 * bj + 16 * n + 4 * fq));
                    }
                } else if (row < MV) {
                    const int nn = row - MPR;
                    if (kind == 0) { float* sd = (float*)(wsb + WS_QS) + ((size_t)nn * 20 + idx) * 64;
#pragma unroll
                        for (int bj = 0; bj < 2; ++bj)
#pragma unroll
                            for (int n = 0; n < 2; ++n) *(f32x4*)(sd + 32 * bj + 16 * n + 4 * fq) = v[bj][n];
                    } else { float* sd = dout + so_s + ((((size_t)nn * win + (win - 1)) * 2 + (kind - 1)) * H + hs) * 64;
#pragma unroll
                        for (int bj = 0; bj < 2; ++bj)
#pragma unroll
                            for (int n = 0; n < 2; ++n) *(f32x4*)(sd + 32 * bj + 16 * n + 4 * fq) = v[bj][n];
                    }
                }
            }
    }
};
struct EpiUp {
    static constexpr bool PERM = true, AFTER_DRAIN = false; static constexpr int HOOK_T = 8;
    const bf16* G; bf16* MIXB;
    __device__ __forceinline__ void hook(f32x4 (&acc)[2][2][4][2], const pg8::Unit& u, int wr, int wc, int fr_, int fq) const {
        int fr = fr_; asm volatile("" : "+v"(fr));
        const int row0 = u.pm * 256 + wr * 64 + fr, col0 = u.pn * 256 + wc * 32 + 8 * fq;
#pragma unroll
        for (int ai = 0; ai < 2; ++ai)
#pragma unroll
            for (int m = 0; m < 4; ++m) { const int row = row0 + ai * 128 + m * 16;
#pragma unroll
                for (int bj = 0; bj < 2; ++bj) { const int col = col0 + bj * 128;
                    const unsigned goff = (unsigned)(row * 2048 + col) * 2u;
                    const u32x4 ga = *(const u32x4*)((const char*)G + goff), gb = *(const u32x4*)((const char*)G + goff + 2048u);
#define RT(a, b) ((a) * __builtin_amdgcn_rcpf(fmaxf((b), 1e-20f)))
                    const f32x4 r0 = {RT(bf2f(ga.x & 0xffff), bf2f(gb.x & 0xffff)), RT(bf2f(ga.x >> 16), bf2f(gb.x >> 16)), RT(bf2f(ga.y & 0xffff), bf2f(gb.y & 0xffff)), RT(bf2f(ga.y >> 16), bf2f(gb.y >> 16))};
                    const f32x4 r1 = {RT(bf2f(ga.z & 0xffff), bf2f(gb.z & 0xffff)), RT(bf2f(ga.z >> 16), bf2f(gb.z >> 16)), RT(bf2f(ga.w & 0xffff), bf2f(gb.w & 0xffff)), RT(bf2f(ga.w >> 16), bf2f(gb.w >> 16))};
#undef RT
                    acc[ai][bj][m][0] = acc[ai][bj][m][0] * r0; acc[ai][bj][m][1] = acc[ai][bj][m][1] * r1;
                    asm volatile("" ::: "memory"); } }
    }
    __device__ __forceinline__ void operator()(const f32x4 (&acc)[2][2][4][2], const pg8::Unit& u, int wr, int wc, int fr, int fq) const {
        const int row0 = u.pm * 256 + wr * 64 + fr, col0 = u.pn * 256 + wc * 32 + 8 * fq;
#pragma unroll
        for (int ai = 0; ai < 2; ++ai)
#pragma unroll
            for (int m = 0; m < 4; ++m) { const int row = row0 + ai * 128 + m * 16;
#pragma unroll
                for (int bj = 0; bj < 2; ++bj) { const int col = col0 + bj * 128;
                    const u32x4 gb = *(const u32x4*)(G + (size_t)row * 2048 + 1024 + col);
                    const f32x4 g0 = {fmaxf(bf2f(gb.x & 0xffff), 1e-20f), fmaxf(bf2f(gb.x >> 16), 1e-20f), fmaxf(bf2f(gb.y & 0xffff), 1e-20f), fmaxf(bf2f(gb.y >> 16), 1e-20f)};
                    const f32x4 g1 = {fmaxf(bf2f(gb.z & 0xffff), 1e-20f), fmaxf(bf2f(gb.z >> 16), 1e-20f), fmaxf(bf2f(gb.w & 0xffff), 1e-20f), fmaxf(bf2f(gb.w >> 16), 1e-20f)};
                    const f32x4 v0 = acc[ai][bj][m][0] * g0, v1 = acc[ai][bj][m][1] * g1;
                    u32x4 w; w.x = cvt_pk_bf16(v0[0], v0[1]); w.y = cvt_pk_bf16(v0[2], v0[3]); w.z = cvt_pk_bf16(v1[0], v1[1]); w.w = cvt_pk_bf16(v1[2], v1[3]);
                    *(u32x4*)(MIXB + (size_t)row * DM + col) = w; } }
    }
};

__device__ __forceinline__ int crow_c(int r) { return (r & 3) + 8 * (r >> 2); }
__device__ __forceinline__ s16x4 vtr(const LAS unsigned char* p) { typedef short v4i16_t __attribute__((ext_vector_type(4))); return __builtin_bit_cast(s16x4, __builtin_amdgcn_ds_read_tr16_b64_v4i16((LAS v4i16_t*)p)); }

__device__ __forceinline__ void phase_attention(KParams P, LAS unsigned char* lds, const int wave_sg) {
    const int tid = TID_NOW(wave_sg), lane = tid & 63, wave = wave_sg;
    unsigned char* ws = P->ws;
    const bf16* QP = (const bf16*)(ws + WS_QP); const bf16* KP = (const bf16*)(ws + WS_KP); const bf16* VP = (const bf16*)(ws + WS_VP);
    const float* QS = (const float*)(ws + WS_QS);
    bf16* OA = (bf16*)(ws + WS_XAB); bf16* OB3 = (bf16*)(ws + WS_OB3); float* LSE3 = (float*)(ws + WS_LSE3);
    const float* sinks = P->in[16];
    {
        LAS float* pl = (LAS float*)(lds + ATT_PL) + wave * 192;
        for (int widx = blockIdx.x * 8 + wave; widx < NS * 20; widx += gridDim.x * 8) {
            const int n = widx / 20, hq = widx % 20;
            const float* cache; int H, L, dil, h; size_t so; int g = 0, slot = 0;
            if (hq < 8) { cache = P->in[2]; H = 2; L = 128; dil = 1; h = hq >> 2; so = O_AS; }
            else { const int jj = hq - 8; g = jj >> 2; slot = jj & 3; h = slot; H = 4; dil = 1 << (2 * g); L = 128 * dil; cache = (g > 1) ? P->in[5] : (g > 0 ? P->in[4] : P->in[3]); so = O_B1S + (g > 0 ? O_B2S - O_B1S : 0) + (g > 1 ? O_B3S - O_B2S : 0); }
            const float slope2 = exp2f(-0.4f * (float)(hq + 1)) * LOG2E * (float)dil;
            const float* newk = P->out + so + ((((size_t)n * L + (L - 1)) * 2 + 0) * H + h) * 64;
            const float* newv = newk + H * 64;
            const float* cb = cache + (size_t)n * L * 2 * H * 64;
            const f32x4* q4 = (const f32x4*)(QS + ((size_t)n * 20 + hq) * 64);
            float sv[3];
#pragma unroll
            for (int rd = 0; rd < 3; ++rd) {
                const int mm = lane + 64 * rd; const bool valid = mm <= 128; const int mc = valid ? mm : 0;
                const f32x4* k4 = (const f32x4*)((mc == 0) ? newk : cb + ((size_t)(L - dil * mc) * 2 * H + h) * 64);
                float dot = 0.f;
#pragma unroll
                for (int d = 0; d < 16; ++d) { const f32x4 a = q4[d], b = k4[d]; dot += (a[0] * b[0] + a[1] * b[1]) + (a[2] * b[2] + a[3] * b[3]); }
                sv[rd] = valid ? dot - slope2 * (float)mm : -1e30f;
            }
            float mx = wave_max(fmaxf(fmaxf(sv[0], sv[1]), sv[2]));
            float sink2 = 0.f;
            if (hq < 8) { sink2 = sinks[hq] * LOG2E; mx = fmaxf(mx, sink2); }
            float lsum = 0.f;
#pragma unroll
            for (int rd = 0; rd < 3; ++rd) { const float p = __builtin_amdgcn_exp2f(sv[rd] - mx); pl[lane + 64 * rd] = p; lsum += p; }
            lsum = wave_sum(lsum);
            if (hq < 8) lsum += __builtin_amdgcn_exp2f(sink2 - mx);
            asm volatile("s_waitcnt lgkmcnt(0)" ::: "memory");
            const int kg = lane >> 4, dq = lane & 15;
            f32x4 o4 = {0.f, 0.f, 0.f, 0.f};
#pragma unroll
            for (int i0 = 0; i0 < 33; i0 += 11) {
                f32x4 vv[11]; float pp[11];
#pragma unroll
                for (int i = 0; i < 11; ++i) { const int mm = 4 * (i0 + i) + kg; const int mc = mm <= 128 ? mm : 128;
                    const float* vp = (mc == 0) ? newv : cb + ((size_t)(L - dil * mc) * 2 * H + H + h) * 64;
                    vv[i] = *(const f32x4*)(vp + 4 * dq); pp[i] = pl[mm]; }
#pragma unroll
                for (int i = 0; i < 11; ++i) o4 = o4 + vv[i] * pp[i];
            }
#pragma unroll
            for (int c = 0; c < 4; ++c) { o4[c] += __shfl_xor(o4[c], 16); o4[c] += __shfl_xor(o4[c], 32); }
            const float il = __builtin_amdgcn_rcpf(lsum);
            const size_t row = MPR + n;
            u32x2 ow; ow.x = cvt_pk_bf16(o4[0] * il, o4[1] * il); ow.y = cvt_pk_bf16(o4[2] * il, o4[3] * il);
            if (hq < 8) { if (kg == 0) *(u32x2*)(OA + row * 768 + hq * 64 + 4 * dq) = ow; }
            else { if (kg == 0) *(u32x2*)(OB3 + ((size_t)g * MP + row) * 256 + slot * 64 + 4 * dq) = ow; if (lane == 0) LSE3[((size_t)g * MP + row) * 4 + slot] = (mx + __builtin_amdgcn_logf(lsum)) * LN2; }
            asm volatile("s_waitcnt lgkmcnt(0)" ::: "memory");
        }
    }
    const int half = wave >> 2, w = wave & 3, r32 = lane & 31, hi = lane >> 5, htid = tid & 255;
    LAS unsigned char* Kl = lds + half * ATT_HALF; LAS unsigned char* Vl = Kl + 256 * ATT_KROW;
    u32x4 kreg[8], vreg[8]; bf16x8 qn[4];
#define ATT_DECODE(pair_) const int it = 2 * (pair_) + half, b = it / 320, rem = it - 320 * b, hq = rem >> 4, j = rem & 15; \
        const int jj = hq - 8, g = hq < 8 ? 0 : (jj >> 2), slot = jj & 3, kidx = hq < 8 ? (hq >> 2) : 2 + jj, dil = 1 << (2 * g)
#define ATT_LOAD(pair_) do { ATT_DECODE(pair_); const int krow0 = 128 * j - 128; \
        const bf16* Kg = KP + ((size_t)(b * 14 + kidx) * 2048) * 64; const bf16* Vg = VP + ((size_t)(b * 14 + kidx) * 2048) * 64; \
        const bf16* Qg = QP + ((size_t)(b * 20 + hq) * 2048 + 128 * j + 32 * w + r32) * 64 + hi * 8; \
        _Pragma("unroll") for (int d0 = 0; d0 < 4; ++d0) qn[d0] = *(const bf16x8*)(Qg + d0 * 16); \
        _Pragma("unroll") for (int c = 0; c < 8; ++c) { const int ch = htid + 256 * c; int grow = krow0 + (ch >> 3); grow = grow < 0 ? grow + 128 : grow; const size_t off = (size_t)grow * 64 + (ch & 7) * 8; \
            kreg[c] = *(const u32x4*)(Kg + off); vreg[c] = *(const u32x4*)(Vg + off); } } while (0)
    if ((int)blockIdx.x < 2560) ATT_LOAD((int)blockIdx.x);
    for (int pair = blockIdx.x; pair < 2560; pair += gridDim.x) {
        ATT_DECODE(pair);
        const int nblk = 16 >> (2 * g), blk = j & (nblk - 1), rres = j >> (4 - 2 * g); const bool hasprev = blk != 0;
        const float sd = exp2f(-0.4f * (float)(hq + 1)) * LOG2E * (float)dil;
        __syncthreads();
#pragma unroll
        for (int c = 0; c < 8; ++c) { const int ch = htid + 256 * c, row = ch >> 3, cc = ch & 7; *(LAS u32x4*)(Kl + row * ATT_KROW + cc * 16) = kreg[c]; *(LAS u32x4*)(Vl + row * ATT_KROW + cc * 16) = vreg[c]; }
        bf16x8 qf[4];
#pragma unroll
        for (int d0 = 0; d0 < 4; ++d0) qf[d0] = qn[d0];
        __syncthreads();
        if (pair + (int)gridDim.x < 2560) ATT_LOAD(pair + (int)gridDim.x);
        float sink2 = 0.f, mx = -1e30f, lsum = 0.f;
        if (hq < 8) { sink2 = sinks[hq] * LOG2E; mx = sink2; lsum = hi == 0 ? 1.f : 0.f; }
        f32x16 o[2];
        o[0] = (f32x16){0.f, 0.f, 0.f, 0.f, 0.f, 0.f, 0.f, 0.f, 0.f, 0.f, 0.f, 0.f, 0.f, 0.f, 0.f, 0.f}; o[1] = o[0];
        const LAS unsigned char* vb = Vl + (32 * w + 4 * hi + ((lane & 15) >> 2)) * ATT_KROW + (16 * ((lane >> 4) & 1) + 4 * (lane & 3)) * 2;
#pragma unroll
        for (int kbi = 0; kbi < 5; ++kbi) { const int kb = 4 - kbi;
            f32x16 S = (f32x16){0.f, 0.f, 0.f, 0.f, 0.f, 0.f, 0.f, 0.f, 0.f, 0.f, 0.f, 0.f, 0.f, 0.f, 0.f, 0.f};
            const LAS unsigned char* kp = Kl + (32 * w + 32 * kb + r32) * ATT_KROW + hi * 16;
#pragma unroll
            for (int d0 = 0; d0 < 4; ++d0) { const bf16x8 kf = *(const LAS bf16x8*)(kp + d0 * 32); S = __builtin_amdgcn_mfma_f32_32x32x16_bf16(kf, qf[d0], S, 0, 0, 0); }
            float tmax = -1e30f;
#pragma unroll
            for (int r = 0; r < 16; ++r) { const int c = crow_c(r) + 4 * hi; const int dist = r32 + 128 - 32 * kb - c;
                float v = S[r] - sd * (float)dist;
                if (kb == 0) v = dist <= 128 ? v : -1e30f;
                if (kb == 4) v = dist >= 0 ? v : -1e30f;
                if (kb < 4) { const int ki = 32 * w + 32 * kb + c; v = (hasprev || ki >= 128) ? v : -1e30f; }
                S[r] = v; tmax = fmaxf(tmax, v); }
            tmax = fmaxf(tmax, __shfl_xor(tmax, 32));
            const float mnew = fmaxf(mx, tmax);
            if (kbi > 0 && __builtin_amdgcn_ballot_w64(mnew > mx) != 0ull) { const float al = __builtin_amdgcn_exp2f(mx - mnew); lsum *= al;
#pragma unroll
                for (int r = 0; r < 16; ++r) { o[0][r] *= al; o[1][r] *= al; } }
            else if (kbi == 0) lsum *= __builtin_amdgcn_exp2f(mx - mnew);
            mx = mnew;
#pragma unroll
            for (int r = 0; r < 16; ++r) { const float p = __builtin_amdgcn_exp2f(S[r] - mx); S[r] = p; lsum += p; }
#pragma unroll
            for (int kk = 0; kk < 2; ++kk) {
                u32x4 pw; pw.x = cvt_pk_bf16(S[8 * kk + 0], S[8 * kk + 1]); pw.y = cvt_pk_bf16(S[8 * kk + 2], S[8 * kk + 3]); pw.z = cvt_pk_bf16(S[8 * kk + 4], S[8 * kk + 5]); pw.w = cvt_pk_bf16(S[8 * kk + 6], S[8 * kk + 7]);
                const bf16x8 pf = __builtin_bit_cast(bf16x8, pw);
#pragma unroll
                for (int dh = 0; dh < 2; ++dh) {
                    const LAS unsigned char* vp = vb + (32 * kb + 16 * kk) * ATT_KROW + dh * 64;
                    const s16x4 lo = vtr(vp), hh = vtr(vp + 8 * ATT_KROW);
                    const bf16x8 vf = {lo[0], lo[1], lo[2], lo[3], hh[0], hh[1], hh[2], hh[3]};
                    o[dh] = __builtin_amdgcn_mfma_f32_32x32x16_bf16(vf, pf, o[dh], 0, 0, 0);
                }
            }
        }
        lsum += __shfl_xor(lsum, 32);
        const float inv = __builtin_amdgcn_rcpf(lsum);
        const int sq = (blk * 128 + 32 * w + r32) * dil + rres; const size_t row = (size_t)b * 2048 + sq;
        bf16* dst = (hq < 8) ? OA + row * 768 + hq * 64 : OB3 + ((size_t)g * MP + row) * 256 + slot * 64;
#pragma unroll
        for (int dh = 0; dh < 2; ++dh)
#pragma unroll
            for (int c = 0; c < 4; ++c) { u32x2 wv; wv.x = cvt_pk_bf16(o[dh][4 * c] * inv, o[dh][4 * c + 1] * inv); wv.y = cvt_pk_bf16(o[dh][4 * c + 2] * inv, o[dh][4 * c + 3] * inv);
                *(u32x2*)(dst + 32 * dh + 8 * c + 4 * hi) = wv; }
        if (hq >= 8 && hi == 0) LSE3[((size_t)g * MP + row) * 4 + slot] = (mx + __builtin_amdgcn_logf(lsum)) * LN2;
    }
#undef ATT_LOAD
#undef ATT_DECODE
    __syncthreads();
}

__device__ __forceinline__ void phase_merge(KParams P, const int wave_sg) {
    unsigned char* ws = P->ws;
    const bf16* OB3 = (const bf16*)(ws + WS_OB3); const float* LSE3 = (const float*)(ws + WS_LSE3); bf16* OBM = (bf16*)(ws + WS_XAB) + 512;
    const long gtid = (long)blockIdx.x * 512 + TID_NOW(wave_sg), gthreads = (long)gridDim.x * 512;
    for (long i = gtid; i < (long)MV * 32; i += gthreads) {
        const long row = i >> 5; const int ch = (int)(i & 31), slot = ch >> 3;
        float l[3], mx = -1e30f;
#pragma unroll
        for (int g = 0; g < 3; ++g) { l[g] = LSE3[((size_t)g * MP + row) * 4 + slot]; mx = fmaxf(mx, l[g]); }
        float wsum = 0.f;
#pragma unroll
        for (int g = 0; g < 3; ++g) { l[g] = __builtin_amdgcn_exp2f((l[g] - mx) * LOG2E); wsum += l[g]; }
        const float inv = __builtin_amdgcn_rcpf(wsum);
        float a[8] = {0.f, 0.f, 0.f, 0.f, 0.f, 0.f, 0.f, 0.f};
#pragma unroll
        for (int g = 0; g < 3; ++g) { const u32x4 v = *(const u32x4*)(OB3 + ((size_t)g * MP + row) * 256 + ch * 8); const float wg = l[g] * inv;
            a[0] += wg * bf2f(v.x & 0xffff); a[1] += wg * bf2f(v.x >> 16); a[2] += wg * bf2f(v.y & 0xffff); a[3] += wg * bf2f(v.y >> 16);
            a[4] += wg * bf2f(v.z & 0xffff); a[5] += wg * bf2f(v.z >> 16); a[6] += wg * bf2f(v.w & 0xffff); a[7] += wg * bf2f(v.w >> 16); }
        u32x4 o; o.x = cvt_pk_bf16(a[0], a[1]); o.y = cvt_pk_bf16(a[2], a[3]); o.z = cvt_pk_bf16(a[4], a[5]); o.w = cvt_pk_bf16(a[6], a[7]);
        *(u32x4*)(OBM + row * 768 + ch * 8) = o;
    }
}

#define GEMM_PHASE(EPI, A_, B_, N_, K_, E_) do { pg8::Gemm g_{(const bf16*)(A_), (const bf16*)(B_), MP, (N_), (K_)}; pg8::SplitOrder S_; S_.init((N_), (K_), (int)gridDim.x, (int)blockIdx.x, 1, nullptr, nullptr); \
    pg8::gemm_phase<std::remove_reference_t<decltype(E_)>, pg8::SplitOrder, true, true>(lds, g_, S_, E_, wave_sg); } while (0)
#define GEMM_PHASE_BG(EPI, A_, B_, N_, K_, E_, BG_, SPLIT_, ACCI_) do { pg8::Gemm g_{(const bf16*)(A_), (const bf16*)(B_), MP, (N_), (K_)}; pg8::SplitOrder S_; \
    S_.init((N_), (K_), (int)gridDim.x, (int)blockIdx.x, (SPLIT_), (float*)(ws + WS_ACC) + (size_t)(ACCI_) * ACC_FLOATS, (unsigned*)(ws + WS_ACC + 3 * ACC_FLOATS * 4) + 64 * (ACCI_)); \
    pg8::gemm_phase<std::remove_reference_t<decltype(E_)>, pg8::SplitOrder, true, true, std::remove_reference_t<decltype(BG_)>>(lds, g_, S_, E_, wave_sg, BG_); } while (0)
typedef pg8::BgCopy<2047u * 128u, 2048u * 128u, 128u> BgB3;
typedef pg8::BgCopy<511u * 128u, 512u * 128u, 128u> BgB2;
constexpr unsigned BG_IT = 256u * 512u;
constexpr unsigned B3_TOT = 128u * 2047u * 128u, B2_TOT = 128u * 511u * 128u;
constexpr unsigned B3_C1 = 88u * BG_IT, B3_C2 = B3_C1 + 44u * BG_IT, B3_C3 = B3_C2 + 80u * BG_IT;
constexpr unsigned B2_C1 = 44u * BG_IT;
static_assert(B3_TOT - B3_C3 <= 88u * BG_IT && B2_C1 < B2_TOT, "background copy capacity");

#define LOADP(P_) KParams P_ = kp0; asm volatile("" : "+s"(P_)); unsigned char* const ws = P_->ws; (void)ws
__global__ void __launch_bounds__(512, 2) mega_fwd(Params Parg) {
    extern __shared__ __attribute__((aligned(16))) unsigned char lds_raw[];
    LAS unsigned char* lds = (LAS unsigned char*)lds_raw;
    cg::grid_group grid = cg::this_grid();
    const KParams kp0 = (KParams)__builtin_amdgcn_kernarg_segment_ptr();
    const int wave_sg = __builtin_amdgcn_readfirstlane(threadIdx.x >> 6);
    volatile LAS unsigned* xb_st = (volatile LAS unsigned*)(lds + LDS_BYTES - 16);
    if (TID_NOW(wave_sg) < 4) xb_st[TID_NOW(wave_sg)] = 0u;
    __syncthreads();
    const XcdBarrier xbar = xcd_barrier_post((unsigned*)(kp0->ws + WS_BAR), xb_st, wave_sg);
#define GRID_BAR() xcd_barrier(xbar, wave_sg)
    { LOADP(P); phase_prologue(P, lds, wave_sg); }
    grid.sync();
    const int bgr = (gridDim.x == 256) ? 1 : 0;
    { LOADP(P); { EpiSwiGLU E{(bf16*)(ws + WS_H), (const float*)(ws + WS_SS1)}; BgB3 bg{(const f32x4*)P->in[5], (f32x4*)(P->out + O_B3S), (f32x4*)(ws + WS_DUMP), 0u, B3_C1, 11 * bgr};
        GEMM_PHASE_BG(EpiSwiGLU, ws + WS_XB, ws + WS_W1GU, 2 * DFF, DM, E, bg, 1, 0); }
      if (bgr) { idle_copy(P, 129 * 22, 0u, CP_S1, wave_sg); idle_copy(P, 129 * 22, CP_S1 + B2_C1, CP_S2, wave_sg); } }
    GRID_BAR();
    { LOADP(P); { EpiRes<false, false> E{P->in[0], P->in[1], nullptr, nullptr, (bf16*)(ws + WS_X1B), (float*)(ws + WS_SS2), 0.5f}; BgB3 bg{(const f32x4*)P->in[5], (f32x4*)(P->out + O_B3S), (f32x4*)(ws + WS_DUMP), B3_C1, B3_C2, 2 * bgr};
        GEMM_PHASE_BG(0, ws + WS_H, ws + WS_W1D, DM, DFF, E, bg, 11, 0); } }
    GRID_BAR();
    { LOADP(P); { EpiQKV E{(const float*)(ws + WS_SS2), ws, (bf16*)(ws + WS_G), P->out, (const float*)(ws + WS_GT)}; BgB3 bg{(const f32x4*)P->in[5], (f32x4*)(P->out + O_B3S), (f32x4*)(ws + WS_DUMP), B3_C2, B3_C3, 10 * bgr};
        GEMM_PHASE_BG(EpiQKV, ws + WS_X1B, ws + WS_WIN, INW, DM, E, bg, 1, 0); } }
    GRID_BAR();
    { LOADP(P); phase_attention(P, lds, wave_sg); }
    GRID_BAR();
    { LOADP(P); phase_merge(P, wave_sg); }
    GRID_BAR();
    { LOADP(P); EpiUp E{(const bf16*)(ws + WS_G), (bf16*)(ws + WS_MIXB)}; GEMM_PHASE(EpiUp, ws + WS_XAB, ws + WS_WUA, DM, 768, E); }
    GRID_BAR();
    { LOADP(P); { EpiRes<true, false> E{nullptr, nullptr, (const bf16*)(ws + WS_X1B), nullptr, (bf16*)(ws + WS_X2B), (float*)(ws + WS_SS3), 1.0f}; pg8::BgNone bg; GEMM_PHASE_BG(0, ws + WS_MIXB, ws + WS_WO, DM, DM, E, bg, 4, 2); } }
    GRID_BAR();
    { LOADP(P); { EpiSwiGLU E{(bf16*)(ws + WS_H), (const float*)(ws + WS_SS3)}; BgB3 bg{(const f32x4*)P->in[5], (f32x4*)(P->out + O_B3S), (f32x4*)(ws + WS_DUMP), B3_C3, B3_TOT, 11 * bgr};
        GEMM_PHASE_BG(EpiSwiGLU, ws + WS_X2B, ws + WS_W2GU, 2 * DFF, DM, E, bg, 1, 0); } }
    GRID_BAR();
    { LOADP(P); { EpiRes<true, true> E{nullptr, nullptr, (const bf16*)(ws + WS_X2B), P->out, nullptr, nullptr, 0.5f}; BgB2 bg{(const f32x4*)P->in[4], (f32x4*)(P->out + O_B2S), (f32x4*)(ws + WS_DUMP), 0u, B2_C1, 2 * bgr};
        GEMM_PHASE_BG(0, ws + WS_H, ws + WS_W2D, DM, DFF, E, bg, 11, 1); } }
}

extern "C" void kernel_launch(void* const* d_in, const int* in_sizes, int n_in, void* d_out, int out_size, void* d_ws, size_t ws_size, hipStream_t stream) {
    static int grid = 0;
    if (grid == 0) {
        if (n_in != 24 || ws_size < WS_END) { fprintf(stderr, "kernel_launch: unexpected n_in %d / ws_size %zu\n", n_in, ws_size); grid = -1; return; }
        int dev = 0, cus = 0, per_cu = 0;
        hipGetDevice(&dev); hipDeviceGetAttribute(&cus, hipDeviceAttributeMultiprocessorCount, dev);
        if (hipFuncSetAttribute((const void*)mega_fwd, hipFuncAttributeMaxDynamicSharedMemorySize, LDS_BYTES) != hipSuccess) { fprintf(stderr, "kernel_launch: hipFuncSetAttribute failed\n"); grid = -1; return; }
        if (hipOccupancyMaxActiveBlocksPerMultiprocessor(&per_cu, (const void*)mega_fwd, 512, LDS_BYTES) != hipSuccess || per_cu < 1) { fprintf(stderr, "kernel_launch: occupancy query says %d\n", per_cu); per_cu = 1; }
        (void)hipGetLastError();
        grid = cus * per_cu;
        fprintf(stderr, "kernel_launch: grid %d (cus %d x %d)\n", grid, cus, per_cu);
    }
    if (grid < 0) return;
    if (hipMemsetAsync((char*)d_ws + WS_BAR, 0, XCD_BAR_WORDS * 4, stream) != hipSuccess) { fprintf(stderr, "kernel_launch: hipMemsetAsync of the barrier words failed\n"); return; }
    Params p{};
    for (int i = 0; i < 24; ++i) p.in[i] = (const float*)d_in[i];
    p.out = (float*)d_out; p.ws = (unsigned char*)d_ws;
    void* args[] = {&p};
    hipError_t e = hipLaunchCooperativeKernel((const void*)mega_fwd, dim3(grid), dim3(512), args, LDS_BYTES, stream);
    if (e != hipSuccess) fprintf(stderr, "cooperative launch failed: %s (grid %d)\n", hipGetErrorString(e), grid);
}
```

```cpp
#include <hip/hip_runtime.h>
#include <hip/hip_cooperative_groups.h>
#include <cstdio>
#include <cstdint>
#include <type_traits>
namespace cg = cooperative_groups;
namespace pg8 {
#define PG8_LAS __attribute__((address_space(3)))
typedef unsigned short bf16_t;
typedef short bf16x8 __attribute__((ext_vector_type(8)));
typedef float f32x4 __attribute__((ext_vector_type(4)));
typedef unsigned u32x4 __attribute__((ext_vector_type(4)));
constexpr int BM = 256, BK = 64, HALF = 128, HTB = HALF * BK * 2  , STAGE_BYTES = 8 * HTB, NXCD = 8, WGM = 8;

__host__ __device__ __forceinline__ int lds_byte(int r, int c) { const int st = (r >> 4) * 2 + (c >> 5), rr = r & 15, cc = c & 31, ob = rr * 64 + cc * 2; return st * 1024 + (ob ^ (((ob >> 9) & 1) << 5)); }
__host__ __device__ __forceinline__ void stage_rc(int b, int& R, int& C) { const int st = b / 1024, sb = b % 1024, swz = sb ^ (((sb >> 9) & 1) << 5); R = (st >> 1) * 16 + swz / 64; C = (st & 1) * 32 + (swz % 64) / 2; }
__host__ __device__ __forceinline__ int perm32(int rho) { const int n = rho >> 4, i = rho & 15; return 8 * (i >> 2) + 4 * n + (i & 3); }

struct Unit { int pm, pn, kt0, nt, split; };
struct Gemm { const bf16_t* A; const bf16_t* Bt; int M, N, K; };

struct StaticOrder {
    int nM, nN, nwg, G, c;
    __host__ __device__ void init(int M, int N, int G_, int c_) { nM = M / BM; nN = N / BM; nwg = nM * nN; G = G_; c = c_; }
    __host__ __device__ bool next(int i, Unit& u) const {
        const long L = (long)i * G + c; if (L >= nwg) return false;
        int wgid = (int)L; { const int q = nwg / NXCD, r = nwg % NXCD, xcd = wgid % NXCD, off = wgid / NXCD; wgid = (xcd < r ? xcd * (q + 1) : r * (q + 1) + (xcd - r) * q) + off; }
        const int nig = WGM * nN, gid = wgid / nig, fm = gid * WGM, gsz = (nM - fm) < WGM ? (nM - fm) : WGM;
        u.pm = fm + ((wgid % nig) % gsz); u.pn = (wgid % nig) / gsz; u.kt0 = 0; u.nt = ntK; u.split = 1; return true;
    }
    __device__ __forceinline__ void a_ready(const Unit&) const {}
    __device__ __forceinline__ void done(const Unit&) const {}
    int ntK; float* acc_buf; unsigned* cnt;
};
struct SplitOrder {
    StaticOrder so; int nmain, ntot, S, ntK; float* acc_buf; unsigned* cnt;
    __host__ __device__ void init(int N, int K, int G_, int c_, int S_, float* ab, unsigned* cn) { so.init(128 * BM, N, G_, c_); so.ntK = K / BK; nmain = so.nwg; S = S_; ntK = K / BK; ntot = nmain + so.nN * S; acc_buf = ab; cnt = cn; }
    __host__ __device__ __forceinline__ bool next(int i, Unit& u) const {
        const long L = (long)i * so.G + so.c; if (L >= ntot) return false;
        int pm, pn, kt0 = 0, n = ntK, sp = 1;
        if (L < nmain) {
            int wgid = (int)L; { const int nwg = nmain, q = nwg / NXCD, r = nwg % NXCD, xcd = wgid % NXCD, off = wgid / NXCD; wgid = (xcd < r ? xcd * (q + 1) : r * (q + 1) + (xcd - r) * q) + off; }
            const int nig = WGM * so.nN, gid = wgid / nig, fm = gid * WGM, gsz = (128 - fm) < WGM ? (128 - fm) : WGM;
            pm = fm + ((wgid % nig) % gsz); pn = (wgid % nig) / gsz;
        } else { const int e = (int)L - nmain; pm = 128; pn = e / S; n = ntK / S; kt0 = (e - pn * S) * n; sp = S; }
        u.pm = pm; u.pn = pn; u.kt0 = kt0; u.nt = n; u.split = sp; return true;
    }
    __device__ __forceinline__ void a_ready(const Unit&) const {}
    __device__ __forceinline__ void done(const Unit&) const {}
};

__device__ __forceinline__ unsigned cvt_pk_bf16(float lo, float hi) { unsigned r; asm volatile("v_cvt_pk_bf16_f32 %0, %1, %2" : "=v"(r) : "v"(lo), "v"(hi)); return r; }
typedef float f32x2 __attribute__((ext_vector_type(2)));
struct BgNone { static constexpr unsigned PER = 0; };
template <unsigned PER_, unsigned LR4_, unsigned R4_> struct BgCopy { static constexpr unsigned PER = PER_, LR4 = LR4_, R4 = R4_; const f32x4* src; f32x4* dst; f32x4* dump; unsigned lo, hi; int rounds; };
template <class Epi, class Sched, bool ALIGN_EPI = false, bool SP2 = false, class Bg = BgNone>
__device__ __forceinline__ void gemm_phase(PG8_LAS unsigned char* lds, const Gemm g, const Sched& S, const Epi& E, const int wave_sg, const Bg& bg = Bg()) {
    int tid_; asm volatile("v_mbcnt_lo_u32_b32 %0, -1, 0\n\tv_mbcnt_hi_u32_b32 %0, -1, %0\n\tv_lshl_or_b32 %0, %1, 6, %0" : "=&v"(tid_) : "s"(wave_sg));
    const int tid = tid_, wid = __builtin_amdgcn_readfirstlane(tid >> 6), lane = tid & 63, wr = wid >> 2, wc = wid & 3, fr = lane & 15, fq = lane >> 4;
    const int K = g.K, nt = K / BK;
    unsigned voffA[2], voffB[2];
#pragma unroll
    for (int i = 0; i < 2; ++i) { int R, C; stage_rc(tid * 16 + i * 8192, R, C); const int Rb = Epi::PERM ? ((R & ~31) + perm32(R & 31)) : R;
        voffA[i] = (unsigned)(R * K + C) * 2u; voffB[i] = (unsigned)(Rb * K + C) * 2u; }
    const size_t kstep = (size_t)(BK * 2);
    const size_t hstep = (size_t)HALF * K * 2;
    const size_t tstep = 2 * hstep;
    const unsigned ldsw = (unsigned)wid * 1024u;
    const int aoff = lds_byte(wr * 64 + fr, fq * 8), boff = lds_byte(wc * 32 + fr, fq * 8);
#define PG8_SA(b, h) (((b) * 2 + (h)) * HTB)
#define PG8_SB(b, h) ((4 + (b) * 2 + (h)) * HTB)
#define PG8_STAGE(bufoff, gbase, voff) do { _Pragma("unroll") for (int _i = 0; _i < 2; ++_i) \
        __builtin_amdgcn_global_load_lds((const unsigned*)((const char*)(gbase) + (voff)[_i]), (PG8_LAS unsigned*)(lds + (bufoff) + ldsw + _i * 8192), 16, 0, 0); } while (0)
#define PG8_LDA(dst, b, h) do { _Pragma("unroll") for (int m = 0; m < 4; ++m) _Pragma("unroll") for (int k = 0; k < 2; ++k) dst[m][k] = *(const PG8_LAS bf16x8*)(lds + PG8_SA(b, h) + aoff + m * 2048 + k * 1024); } while (0)
#define PG8_LDB(dst, b, h) do { _Pragma("unroll") for (int n = 0; n < 2; ++n) _Pragma("unroll") for (int k = 0; k < 2; ++k) dst[n][k] = *(const PG8_LAS bf16x8*)(lds + PG8_SB(b, h) + boff + n * 2048 + k * 1024); } while (0)
#define PG8_MMA(ai, bj, At, Bt) do { __builtin_amdgcn_s_setprio(1); _Pragma("unroll") for (int m = 0; m < 4; ++m) _Pragma("unroll") for (int n = 0; n < 2; ++n) _Pragma("unroll") for (int k = 0; k < 2; ++k) \
        acc[ai][bj][m][n] = __builtin_amdgcn_mfma_f32_16x16x32_bf16(Bt[n][k], At[m][k], acc[ai][bj][m][n], 0, 0, 0); __builtin_amdgcn_s_setprio(0); } while (0)
#define PG8_WAIT_V(n) asm volatile("s_waitcnt vmcnt(" #n ")" ::: "memory")
#define PG8_WAIT_L(n) asm volatile("s_waitcnt lgkmcnt(" #n ")" ::: "memory")
#define PG8_BAR __builtin_amdgcn_s_barrier()
#define PG8_SCHED __builtin_amdgcn_sched_barrier(0)
    Unit cur, nxt; int ui = 0;
    f32x4 bgdata = {0.f, 0.f, 0.f, 0.f}; f32x4* bgdst = nullptr;
    if constexpr (Bg::PER != 0) bgdst = bg.dump + (size_t)blockIdx.x * 512 + tid;
    if (!S.next(0, cur)) return;
    f32x4 acc[2][2][4][2];
#pragma unroll
    for (int a = 0; a < 2; ++a)
#pragma unroll
        for (int b = 0; b < 2; ++b)
#pragma unroll
            for (int m = 0; m < 4; ++m)
#pragma unroll
                for (int n = 0; n < 2; ++n) acc[a][b][m][n] = (f32x4){0.f, 0.f, 0.f, 0.f};
    bf16x8 At[4][2], B0[2][2], B1[2][2];
    const char* cA = (const char*)g.A + (size_t)cur.pm * tstep + (size_t)cur.kt0 * kstep; const char* cB = (const char*)g.Bt + (size_t)cur.pn * tstep + (size_t)cur.kt0 * kstep;
    S.a_ready(cur);
    if constexpr (SP2) {
        PG8_STAGE(PG8_SB(0, 0), cB, voffB); PG8_STAGE(PG8_SB(0, 1), cB + hstep, voffB); PG8_STAGE(PG8_SA(0, 0), cA, voffA); PG8_STAGE(PG8_SA(0, 1), cA + hstep, voffA);
        if (wr == 1) PG8_BAR;
        PG8_WAIT_V(2); PG8_BAR;
        PG8_STAGE(PG8_SB(1, 0), cB + kstep, voffB); PG8_STAGE(PG8_SA(1, 0), cA + kstep, voffA); PG8_STAGE(PG8_SB(1, 1), cB + hstep + kstep, voffB);
        PG8_WAIT_V(6); PG8_BAR;
    } else {
        PG8_STAGE(PG8_SB(0, 0), cB, voffB); PG8_STAGE(PG8_SA(0, 0), cA, voffA); PG8_STAGE(PG8_SB(0, 1), cB + hstep, voffB); PG8_STAGE(PG8_SA(0, 1), cA + hstep, voffA);
        if (wr == 1) PG8_BAR;
        PG8_WAIT_V(4); PG8_BAR;
        PG8_STAGE(PG8_SB(1, 0), cB + kstep, voffB); PG8_STAGE(PG8_SA(1, 0), cA + kstep, voffA); PG8_STAGE(PG8_SB(1, 1), cB + hstep + kstep, voffB);
        PG8_WAIT_V(6); PG8_BAR;
    }
    for (;;) {
        const bool has_next = S.next(ui + 1, nxt);
        const char* nA = has_next ? (const char*)g.A + (size_t)nxt.pm * tstep + (size_t)nxt.kt0 * kstep : cA; const char* nB = has_next ? (const char*)g.Bt + (size_t)nxt.pn * tstep + (size_t)nxt.kt0 * kstep : cB;
        const int cnt_ = cur.nt;
        for (int t = 0; t < cnt_; t += 2) {
            if constexpr (Epi::HOOK_T >= 0) { if (t == Epi::HOOK_T) E.hook(acc, cur, wr, wc, fr, fq); }
            const bool last = (t == cnt_ - 2);
            const char* a1 = cA + (size_t)(t + 1) * kstep;
            const char* a2 = last ? nA : cA + (size_t)(t + 2) * kstep; const char* b2 = last ? nB : cB + (size_t)(t + 2) * kstep;
            const char* a3 = a2 + kstep; const char* b3 = b2 + kstep;
            if (last && has_next) S.a_ready(nxt);
            if constexpr (SP2) {
            bool bg_on = false;
            if constexpr (Bg::PER != 0) { bg_on = ui < bg.rounds;
                if (bg_on) {
                    const unsigned idx = bg.lo + (unsigned)((ui * (nt >> 1) + (t >> 1)) * (int)gridDim.x + (int)blockIdx.x) * 512u + (unsigned)tid; const bool ok = idx < bg.hi;
                    const unsigned n = idx / Bg::PER, j = idx - n * Bg::PER; const size_t so = (size_t)n * Bg::LR4 + j;
                    const f32x4* sp = ok ? bg.src + so + Bg::R4 : bg.src; f32x4* nd = ok ? bg.dst + so : bg.dump + (size_t)blockIdx.x * 512 + tid;
                    asm volatile("global_store_dwordx4 %1, %0, off nt\n\tglobal_load_dwordx4 %0, %2, off nt" : "+v"(bgdata) : "v"(bgdst), "v"(sp) : "memory");
                    bgdst = nd; } }
            PG8_LDB(B0, 0, 0); PG8_LDB(B1, 0, 1); PG8_SCHED; PG8_LDA(At, 0, 0); PG8_STAGE(PG8_SA(1, 1), a1 + hstep, voffA);
            if (bg_on) { PG8_WAIT_V(10); } else { PG8_WAIT_V(8); } PG8_WAIT_L(0); PG8_BAR; PG8_MMA(0, 0, At, B0); PG8_MMA(0, 1, At, B1); PG8_BAR; PG8_SCHED;
            PG8_LDA(At, 0, 1); PG8_STAGE(PG8_SB(0, 0), b2, voffB); PG8_STAGE(PG8_SB(0, 1), b2 + hstep, voffB); PG8_STAGE(PG8_SA(0, 0), a2, voffA);
            if (bg_on) { PG8_WAIT_V(10); } else { PG8_WAIT_V(8); } PG8_WAIT_L(0); PG8_BAR; PG8_MMA(1, 0, At, B0); PG8_MMA(1, 1, At, B1); PG8_BAR; PG8_SCHED;
            PG8_LDB(B0, 1, 0); PG8_LDB(B1, 1, 1); PG8_SCHED; PG8_LDA(At, 1, 0); PG8_STAGE(PG8_SA(0, 1), a2 + hstep, voffA);
            PG8_WAIT_V(8); PG8_WAIT_L(0); PG8_BAR; PG8_MMA(0, 0, At, B0); PG8_MMA(0, 1, At, B1); PG8_BAR; PG8_SCHED;
            PG8_LDA(At, 1, 1); PG8_STAGE(PG8_SB(1, 0), b3, voffB); PG8_STAGE(PG8_SB(1, 1), b3 + hstep, voffB); PG8_STAGE(PG8_SA(1, 0), a3, voffA);
            PG8_WAIT_V(8); PG8_WAIT_L(0); PG8_BAR; PG8_MMA(1, 0, At, B0); PG8_MMA(1, 1, At, B1); PG8_BAR; PG8_SCHED;
            } else {
            PG8_LDB(B0, 0, 0); PG8_SCHED; PG8_LDA(At, 0, 0); PG8_STAGE(PG8_SA(1, 1), a1 + hstep, voffA);
            PG8_WAIT_L(8); PG8_BAR; PG8_WAIT_L(0); PG8_MMA(0, 0, At, B0); PG8_BAR; PG8_SCHED;
            PG8_LDB(B1, 0, 1); PG8_STAGE(PG8_SB(0, 0), b2, voffB);
            PG8_BAR; PG8_WAIT_L(0); PG8_MMA(0, 1, At, B1); PG8_BAR;
            PG8_LDA(At, 0, 1); PG8_STAGE(PG8_SA(0, 0), a2, voffA);
            PG8_BAR; PG8_WAIT_L(0); PG8_MMA(1, 0, At, B0); PG8_BAR; PG8_SCHED;
            PG8_STAGE(PG8_SB(0, 1), b2 + hstep, voffB);
            PG8_WAIT_V(6); PG8_BAR; PG8_MMA(1, 1, At, B1); PG8_BAR;
            PG8_LDB(B0, 1, 0); PG8_SCHED; PG8_LDA(At, 1, 0); PG8_STAGE(PG8_SA(0, 1), a2 + hstep, voffA);
            PG8_WAIT_L(8); PG8_BAR; PG8_WAIT_L(0); PG8_MMA(0, 0, At, B0); PG8_BAR; PG8_SCHED;
            PG8_LDB(B1, 1, 1); PG8_STAGE(PG8_SB(1, 0), b3, voffB);
            PG8_BAR; PG8_WAIT_L(0); PG8_MMA(0, 1, At, B1); PG8_BAR;
            PG8_LDA(At, 1, 1); PG8_STAGE(PG8_SA(1, 0), a3, voffA);
            PG8_BAR; PG8_WAIT_L(0); PG8_MMA(1, 0, At, B0); PG8_BAR; PG8_SCHED;
            PG8_STAGE(PG8_SB(1, 1), b3 + hstep, voffB);
            PG8_WAIT_V(6); PG8_BAR; PG8_MMA(1, 1, At, B1); PG8_BAR;
            }
        }
        if constexpr (ALIGN_EPI) { if (wr == 0) PG8_BAR; }
        if (cur.split > 1) {
            float* ab = S.acc_buf + (size_t)cur.pn * (64 * 512) + tid;
#pragma unroll
            for (int m = 0; m < 4; ++m)
#pragma unroll
                for (int bj = 0; bj < 2; ++bj)
#pragma unroll
                    for (int n = 0; n < 2; ++n)
#pragma unroll
                        for (int c = 0; c < 4; ++c) unsafeAtomicAdd(ab + (((m * 2 + bj) * 2 + n) * 4 + c) * 512, acc[0][bj][m][n][c]);
            __threadfence();
            PG8_LAS unsigned* flag = (PG8_LAS unsigned*)(lds + STAGE_BYTES);
            PG8_BAR;
            if (tid == 0) { const unsigned old = __hip_atomic_fetch_add(S.cnt + cur.pn, 1u, __ATOMIC_ACQ_REL, __HIP_MEMORY_SCOPE_AGENT); *flag = (old == (unsigned)cur.split - 1u) ? 1u : 0u; }
            asm volatile("s_waitcnt lgkmcnt(0)" ::: "memory"); PG8_BAR; asm volatile("" ::: "memory");
            const bool lastone = *flag != 0u;
            asm volatile("s_waitcnt lgkmcnt(0)" ::: "memory"); PG8_BAR;
            if (lastone) { __threadfence();
#pragma unroll
                for (int m = 0; m < 4; ++m)
#pragma unroll
                    for (int bj = 0; bj < 2; ++bj)
#pragma unroll
                        for (int n = 0; n < 2; ++n) {
#pragma unroll
                            for (int c = 0; c < 4; ++c) acc[0][bj][m][n][c] = __hip_atomic_load(ab + (((m * 2 + bj) * 2 + n) * 4 + c) * 512, __ATOMIC_RELAXED, __HIP_MEMORY_SCOPE_AGENT);
                            acc[1][bj][m][n] = (f32x4){0.f, 0.f, 0.f, 0.f}; }
                E(acc, cur, wr, wc, fr, fq); }
        } else
        if constexpr (!Epi::AFTER_DRAIN) { E(acc, cur, wr, wc, fr, fq); S.done(cur); }
        if (!has_next) break;
#pragma unroll
        for (int a = 0; a < 2; ++a)
#pragma unroll
            for (int b = 0; b < 2; ++b)
#pragma unroll
                for (int m = 0; m < 4; ++m)
#pragma unroll
                    for (int n = 0; n < 2; ++n) acc[a][b][m][n] = (f32x4){0.f, 0.f, 0.f, 0.f};
        cur = nxt; cA = nA; cB = nB; ++ui;
        if constexpr (ALIGN_EPI) { if (wr == 1) PG8_BAR; }
    }
    if constexpr (Bg::PER != 0) { if (bg.rounds > 0) asm volatile("global_store_dwordx4 %1, %0, off nt" :: "v"(bgdata), "v"(bgdst) : "memory"); }
    PG8_WAIT_V(0);
    if constexpr (!ALIGN_EPI) { if (wr == 0) PG8_BAR; }
    PG8_BAR;
    if constexpr (Epi::AFTER_DRAIN) { E.fused(acc, cur, wr, wc, fr, fq, lds, wid, lane); S.done(cur); }
#undef PG8_SA
#undef PG8_SB
#undef PG8_STAGE
#undef PG8_LDA
#undef PG8_LDB
#undef PG8_MMA
#undef PG8_WAIT_V
#undef PG8_WAIT_L
#undef PG8_BAR
#undef PG8_SCHED
}
}

#ifndef PG8_SP2
#define PG8_SP2 true
#endif
#define LAS __attribute__((address_space(3)))
typedef unsigned short bf16;
typedef pg8::f32x4 f32x4;
typedef pg8::u32x4 u32x4;
typedef pg8::bf16x8 bf16x8;
typedef unsigned u32x2 __attribute__((ext_vector_type(2)));
typedef float f32x16 __attribute__((ext_vector_type(16)));
typedef short s16x4 __attribute__((ext_vector_type(4)));
using pg8::cvt_pk_bf16;

constexpr int DM = 1024, DFF = 2816, SEQ = 2048, MPR = 32768, NS = 128, MV = MPR + NS, MP = 33024, INW = 5120;
constexpr float EPS = 1e-6f;
constexpr float LOG2E = 1.4426950408889634f, LN2 = 0.6931471805599453f;
constexpr float QSCALE = 0.125f * LOG2E;
constexpr size_t MiB = 1u << 20;
constexpr size_t WS_SS1 = 0, WS_SS2 = 256 * 1024, WS_SS3 = 512 * 1024, WS_GT = 768 * 1024;
constexpr size_t WS_W1GU = 1 * MiB, WS_W1D = 13 * MiB, WS_WIN = 19 * MiB, WS_WUA = 29 * MiB, WS_WUB = 30 * MiB, WS_WO = 31 * MiB, WS_W2GU = 33 * MiB, WS_W2D = 45 * MiB;
constexpr size_t WS_XB = 52 * MiB, WS_H = 117 * MiB, WS_X1 = 295 * MiB, WS_X1B = 424 * MiB, WS_QP = 489 * MiB, WS_KP = 569 * MiB, WS_VP = 625 * MiB, WS_QS = 681 * MiB;
constexpr size_t WS_G = 682 * MiB, WS_XAB = 912 * MiB, WS_OB3 = 844 * MiB, WS_LSE3 = 893 * MiB, WS_MIXB = 1041 * MiB, WS_X2B = 1106 * MiB, WS_DUMP = 1171 * MiB, WS_ACC = 1174 * MiB, WS_BAR = 1176 * MiB, WS_END = 1177 * MiB;
constexpr size_t ACC_FLOATS = 4 * 64 * 512;
constexpr size_t O_YP = 0, O_YS = 33554432, O_AP = 33685504, O_B1P = 34209792, O_B2P = 35258368, O_B3P = 39452672, O_AS = 56229888, O_B1S = 60424192, O_B2S = 68812800, O_B3S = 102367232;

constexpr int ATT_KROW = 144, ATT_HALF = 2 * 256 * ATT_KROW, ATT_PL = 2 * ATT_HALF;
constexpr int LDS_BYTES = ATT_PL + 8 * 1024;

__device__ __forceinline__ int tid_now_(int wave_sg) { int t; asm volatile("v_mbcnt_lo_u32_b32 %0, -1, 0\n\tv_mbcnt_hi_u32_b32 %0, -1, %0\n\tv_lshl_or_b32 %0, %1, 6, %0" : "=&v"(t) : "s"(wave_sg)); return t; }
#define TID_NOW(wave_sg) tid_now_(wave_sg)
struct Params {
    const float* in[24];
    float* out;
    unsigned char* ws;
};
typedef const __attribute__((address_space(4))) Params* KParams;
#define XB_TMO      128
#define XB_XCNT(j)  (256  + 64 * (j))
#define XB_XSUB(j)  (1280 + 64 * (j))
#define XB_XGEN(j)  (2304 + 64 * (j))
#define XB_TOP      3328
#define XB_TOPGEN   3392
#define XCD_BAR_WORDS 3456
#define XB_SPIN_CAP (1u << 18)

__device__ __forceinline__ unsigned xb_ld(unsigned* p)              { return __hip_atomic_load(p, __ATOMIC_RELAXED, __HIP_MEMORY_SCOPE_AGENT); }
__device__ __forceinline__ unsigned xb_add(unsigned* p, unsigned v) { return __hip_atomic_fetch_add(p, v, __ATOMIC_RELAXED, __HIP_MEMORY_SCOPE_AGENT); }
__device__ __forceinline__ unsigned xb_xcc_id() { return (unsigned)__builtin_amdgcn_s_getreg((3 << 11) | 20) & 0xFu; }
#define XB_SPIN(cond, bar) do { unsigned _sp = 0; while (cond) { __builtin_amdgcn_s_sleep(1); \
    if ((++_sp & 255u) == 0u) { if (xb_ld(&(bar)[XB_TMO])) break; if (_sp > XB_SPIN_CAP) { atomicAdd(&(bar)[XB_TMO], 1u); break; } } } } while (0)

struct XcdBarrier {
    unsigned* bar; unsigned x;
    volatile LAS unsigned* st;
};

__device__ __forceinline__ XcdBarrier xcd_barrier_post(unsigned* bar, volatile LAS unsigned* st, int wave_sg) {
    XcdBarrier b; b.bar = bar; b.x = xb_xcc_id(); b.st = st;
    if (TID_NOW(wave_sg) == 0) (void)xb_add(&bar[XB_XCNT(b.x)], 1u);
    return b;
}
__device__ __forceinline__ void xcd_barrier_complete(unsigned* bar, unsigned x, unsigned& nloc, unsigned& nx) {
    const unsigned G = gridDim.x * gridDim.y * gridDim.z;
    unsigned sum, cnt, mine, sp = 0u;
    for (;;) {
        sum = 0u; cnt = 0u; mine = 0u;
#pragma unroll
        for (unsigned j = 0; j < 16; ++j) { const unsigned c = xb_ld(&bar[XB_XCNT(j)]); sum += c; cnt += (c > 0u) ? 1u : 0u; mine = (j == x) ? c : mine; }
        if (sum == G) break;
        __builtin_amdgcn_s_sleep(1);
        if ((++sp & 255u) == 0u) { if (xb_ld(&bar[XB_TMO])) break; if (sp > XB_SPIN_CAP) { atomicAdd(&bar[XB_TMO], 1u); break; } }
    }
    nloc = mine > 0u ? mine : 1u; nx = cnt > 0u ? cnt : 1u;
}

__device__ __forceinline__ void xcd_barrier(const XcdBarrier& b, int wave_sg) {
    asm volatile("s_waitcnt vmcnt(0)" ::: "memory");
    __syncthreads();
    if (TID_NOW(wave_sg) == 0) {
        unsigned* bar = b.bar;
        __builtin_amdgcn_s_waitcnt(0);
        unsigned nloc = b.st[0], nx = b.st[1];
        if (nloc == 0u) { xcd_barrier_complete(bar, b.x, nloc, nx); b.st[0] = nloc; b.st[1] = nx; }
        const unsigned old = xb_add(&bar[XB_XSUB(b.x)], 1u);
        const unsigned gen = old / nloc;
        if (old + 1u == (gen + 1u) * nloc) {
            __builtin_amdgcn_fence(__ATOMIC_RELEASE, "agent");
            asm volatile("s_waitcnt vmcnt(0)" ::: "memory");
            const unsigned og = xb_add(&bar[XB_TOP], 1u);
            const unsigned tg = og / nx;
            if (og + 1u == (tg + 1u) * nx) xb_add(&bar[XB_TOPGEN], 1u);
            else XB_SPIN(xb_ld(&bar[XB_TOPGEN]) == tg, bar);
            __builtin_amdgcn_fence(__ATOMIC_ACQUIRE, "agent");
            xb_add(&bar[XB_XGEN(b.x)], 1u);
            asm volatile("s_waitcnt vmcnt(0)" ::: "memory");
        } else {
            XB_SPIN(xb_ld(&bar[XB_XGEN(b.x)]) == gen, bar);
            __builtin_amdgcn_fence(__ATOMIC_ACQUIRE, "agent");
            asm volatile("s_waitcnt vmcnt(0)" ::: "memory");
        }
    }
    __syncthreads();
}


__device__ __forceinline__ float wave_sum(float v) {
#pragma unroll
    for (int o = 1; o < 64; o <<= 1) v += __shfl_xor(v, o);
    return v;
}
__device__ __forceinline__ float wave_max(float v) {
#pragma unroll
    for (int o = 1; o < 64; o <<= 1) v = fmaxf(v, __shfl_xor(v, o));
    return v;
}
__device__ __forceinline__ float bf2f(unsigned short b) { return __builtin_bit_cast(float, (unsigned)b << 16); }
__device__ __forceinline__ float sigmoidf_(float x) { return __builtin_amdgcn_rcpf(1.f + __builtin_amdgcn_exp2f(-x * LOG2E)); }

__device__ __forceinline__ void tr_item(const float* __restrict__ W, int ldw, int k0, int ns0, bf16* WT, int K, int nd0, const float* __restrict__ gain, LAS float* scr, int lane) {
#pragma unroll 16
    for (int i = 0; i < 32; ++i) { const int kk = 2 * i + (lane >> 5); float w = W[(size_t)(k0 + kk) * ldw + ns0 + (lane & 31)]; if (gain) w *= gain[k0 + kk]; scr[kk * 33 + (lane & 31)] = w; }
    asm volatile("s_waitcnt lgkmcnt(0)" ::: "memory");
    const int c = lane & 7;
#pragma unroll
    for (int j = 0; j < 4; ++j) { const int n = (lane >> 3) + 8 * j; const LAS float* s = scr + (8 * c) * 33 + n;
        u32x4 o; o.x = cvt_pk_bf16(s[0 * 33], s[1 * 33]); o.y = cvt_pk_bf16(s[2 * 33], s[3 * 33]); o.z = cvt_pk_bf16(s[4 * 33], s[5 * 33]); o.w = cvt_pk_bf16(s[6 * 33], s[7 * 33]);
        *(u32x4*)(WT + (size_t)(nd0 + n) * K + k0 + 8 * c) = o; }
    asm volatile("s_waitcnt lgkmcnt(0)" ::: "memory");
}
template <int L, int R> __device__ __forceinline__ void copy_seg(const float* __restrict__ src, float* __restrict__ dst, unsigned lo, unsigned hi, unsigned t0, unsigned nthr) {
    constexpr unsigned PER = (unsigned)(L - 1) * R / 4, LR4 = (unsigned)L * R / 4, R4 = R / 4;
    const f32x4* s4 = (const f32x4*)src; f32x4* d4 = (f32x4*)dst;
    unsigned i = lo + t0;
    for (; i + 3 * nthr < hi; i += 4 * nthr) {
        f32x4 v[4];
#pragma unroll
        for (int u = 0; u < 4; ++u) { const unsigned ii = i + u * nthr, n = ii / PER, j = ii - n * PER; v[u] = __builtin_nontemporal_load(s4 + (size_t)n * LR4 + R4 + j); }
#pragma unroll
        for (int u = 0; u < 4; ++u) { const unsigned ii = i + u * nthr, n = ii / PER, j = ii - n * PER; __builtin_nontemporal_store(v[u], d4 + (size_t)n * LR4 + j); }
    }
    for (; i < hi; i += nthr) { const unsigned n = i / PER, j = i - n * PER; __builtin_nontemporal_store(__builtin_nontemporal_load(s4 + (size_t)n * LR4 + R4 + j), d4 + (size_t)n * LR4 + j); }
}
constexpr unsigned CP_S0 = 128u * 127 * 64, CP_S1 = CP_S0 + 128u * 127 * 128, CP_S2 = CP_S1 + 128u * 511 * 128, CP_TOT = CP_S2 + 128u * 2047 * 128;
__device__ __forceinline__ void copy_slice(KParams P, unsigned lo, unsigned hi, unsigned t0, unsigned nthr) {
    if (lo < CP_S0 && hi > 0) copy_seg<128, 256>(P->in[2], P->out + O_AS, lo, hi < CP_S0 ? hi : CP_S0, t0, nthr);
    if (lo < CP_S1 && hi > CP_S0) copy_seg<128, 512>(P->in[3], P->out + O_B1S, (lo > CP_S0 ? lo : CP_S0) - CP_S0, (hi < CP_S1 ? hi : CP_S1) - CP_S0, t0, nthr);
    if (lo < CP_S2 && hi > CP_S1) copy_seg<512, 512>(P->in[4], P->out + O_B2S, (lo > CP_S1 ? lo : CP_S1) - CP_S1, (hi < CP_S2 ? hi : CP_S2) - CP_S1, t0, nthr);
    if (lo < CP_TOT && hi > CP_S2) copy_seg<2048, 512>(P->in[5], P->out + O_B3S, (lo > CP_S2 ? lo : CP_S2) - CP_S2, (hi < CP_TOT ? hi : CP_TOT) - CP_S2, t0, nthr);
}
constexpr unsigned cp_cut(double f) { return (unsigned)(f * (double)CP_TOT) & ~3u; }
constexpr unsigned CPC0 = 0, CPC1 = cp_cut(0.15), CPC2 = cp_cut(0.235), CPC3 = cp_cut(0.485), CPC4 = cp_cut(0.571), CPC5 = cp_cut(0.663), CPC6 = cp_cut(0.75), CPC7 = CP_TOT;
__device__ __forceinline__ void idle_copy(KParams P, int nwg, unsigned lo, unsigned hi, const int wave_sg) {
    const int G = gridDim.x, busy = nwg % G; const int tid = TID_NOW(wave_sg);
    if (busy == 0 || (int)blockIdx.x < busy) { if (busy == 0) copy_slice(P, lo, hi, blockIdx.x * 512 + tid, G * 512); return; }
    copy_slice(P, lo, hi, (blockIdx.x - busy) * 512 + tid, (G - busy) * 512);
}
__device__ __forceinline__ void phase_prologue(KParams P, LAS unsigned char* lds, const int wave_sg) {
    const int tid = TID_NOW(wave_sg), lane = tid & 63, wave = wave_sg;
    const int gw = blockIdx.x * 8 + wave, NGW = gridDim.x * 8;
    unsigned char* ws = P->ws;
    LAS float* scr = (LAS float*)(lds + wave * 16384);
    constexpr int I_GU = 16 * 176, I_D = 44 * 32, I_IN = 16 * 160, I_UA = 8 * 32, I_UB = 4 * 32, I_O = 16 * 32;
    constexpr int NITEMS = 2 * I_GU + 2 * I_D + I_IN + I_UA + I_UB + I_O;
    for (int it = gw; it < NITEMS; it += NGW) {
        int r = it;
        if (r < 2 * I_GU) { const int L = r / I_GU; r -= L * I_GU; const int kb = r / 176, nb = r % 176, nd0 = 32 * nb, pn = nd0 >> 8, bj = (nd0 >> 7) & 1, c = nd0 & 127;
            const float* W = P->in[L ? (bj ? 22 : 21) : (bj ? 8 : 7)];
            tr_item(W, DFF, 64 * kb, 128 * pn + c, (bf16*)(ws + (L ? WS_W2GU : WS_W1GU)), DM, nd0, P->in[L ? 20 : 6], scr, lane); continue; }
        r -= 2 * I_GU;
        if (r < 2 * I_D) { const int L = r / I_D; r -= L * I_D; const int kb = r / 32, nb = r % 32;
            tr_item(P->in[L ? 23 : 9], DM, 64 * kb, 32 * nb, (bf16*)(ws + (L ? WS_W2D : WS_W1D)), DFF, 32 * nb, nullptr, scr, lane); continue; }
        r -= 2 * I_D;
        if (r < I_IN) { const int kb = r / 160, nb = r % 160, nd0 = 32 * nb; int ns0 = nd0;
            if (nd0 < 3072) { const int pn = nd0 >> 8, cl = nd0 & 255, bj = cl >> 7, wc = (cl >> 5) & 3; ns0 = 64 * (4 * pn + wc) + 32 * bj; }
            tr_item(P->in[11], INW, 64 * kb, ns0, (bf16*)(ws + WS_WIN), DM, nd0, P->in[10], scr, lane); continue; }
        r -= I_IN;
        if (r < I_UA) { const int kb = r / 32, nb = r % 32; tr_item(P->in[17], DM, 64 * kb, 32 * nb, (bf16*)(ws + WS_WUA), 768, 32 * nb, nullptr, scr, lane); continue; }
        r -= I_UA;
        if (r < I_UB) { const int kb = r / 32, nb = r % 32; tr_item(P->in[18], DM, 64 * kb, 32 * nb, (bf16*)(ws + WS_WUA) + 512, 768, 32 * nb, nullptr, scr, lane); continue; }
        r -= I_UB;
        { const int kb = r / 32, nb = r % 32; tr_item(P->in[19], DM, 64 * kb, 32 * nb, (bf16*)(ws + WS_WO), DM, 32 * nb, nullptr, scr, lane); }
    }
    float* ss1 = (float*)(ws + WS_SS1); float* ss2 = (float*)(ws + WS_SS2); float* ss3 = (float*)(ws + WS_SS3);
    bf16* XB = (bf16*)(ws + WS_XB);
    for (int m = gw; m < MP; m += NGW) {
        unsigned long long* o8 = (unsigned long long*)(XB + (size_t)m * DM) + lane;
        if (m < MV) {
            const float* xr = (m < MPR) ? P->in[0] + (size_t)m * DM : P->in[1] + (size_t)(m - MPR) * DM;
            const f32x4* x4 = (const f32x4*)xr + lane; f32x4 v[4]; float s = 0.f;
#pragma unroll
            for (int j = 0; j < 4; ++j) { v[j] = x4[64 * j]; s += (v[j].x * v[j].x + v[j].y * v[j].y) + (v[j].z * v[j].z + v[j].w * v[j].w); }
            s = wave_sum(s);
#pragma unroll
            for (int j = 0; j < 4; ++j) o8[64 * j] = (unsigned long long)cvt_pk_bf16(v[j].x, v[j].y) | ((unsigned long long)cvt_pk_bf16(v[j].z, v[j].w) << 32);
            if (lane == 0) ss1[m] = s;
        } else {
#pragma unroll
            for (int j = 0; j < 4; ++j) o8[64 * j] = 0ull;
            if (lane == 0) ss1[m] = 0.f;
        }
    }
    const long gtid = (long)blockIdx.x * 512 + tid, gthreads = (long)gridDim.x * 512;
    for (long i = gtid; i < MP; i += gthreads) { ss2[i] = 0.f; ss3[i] = 0.f; }
    for (long i = gtid; i < (long)(3 * ACC_FLOATS + 3 * 64); i += gthreads) ((float*)(ws + WS_ACC))[i] = 0.f;
    if (blockIdx.x == 0 && tid < 320) { float* GT = (float*)(ws + WS_GT); const int r = tid >> 6, d = tid & 63;
        float v = 1.f; if (r == 0) v = P->in[12][d] * QSCALE; else if (r == 1) v = P->in[13][d]; else if (r == 2) v = P->in[14][d] * QSCALE; else if (r == 3) v = P->in[15][d];
        GT[tid] = v; }
    if (gridDim.x != 256) copy_slice(P, 0u, CP_TOT, (unsigned)gtid, (unsigned)gthreads);
}

struct EpiSwiGLU {
    static constexpr bool PERM = true, AFTER_DRAIN = false; static constexpr int HOOK_T = -1;
    bf16* H; const float* ss;
    __device__ __forceinline__ void operator()(const f32x4 (&acc)[2][2][4][2], const pg8::Unit& u, int wr, int wc, int fr, int fq) const {
        const int row0 = u.pm * 256 + wr * 64 + fr, col0 = u.pn * 128 + wc * 32 + 8 * fq;
#pragma unroll
        for (int ai = 0; ai < 2; ++ai)
#pragma unroll
            for (int m = 0; m < 4; ++m) { const int row = row0 + ai * 128 + m * 16; const float rs = __builtin_amdgcn_rsqf(ss[row] * (1.f / DM) + EPS);
                float h[8];
#pragma unroll
                for (int n = 0; n < 2; ++n)
#pragma unroll
                    for (int j = 0; j < 4; ++j) { const float g = acc[ai][0][m][n][j] * rs, up = acc[ai][1][m][n][j] * rs; h[4 * n + j] = g * sigmoidf_(g) * up; }
                u32x4 w; w.x = cvt_pk_bf16(h[0], h[1]); w.y = cvt_pk_bf16(h[2], h[3]); w.z = cvt_pk_bf16(h[4], h[5]); w.w = cvt_pk_bf16(h[6], h[7]);
                *(u32x4*)(H + (size_t)row * DFF + col0) = w; }
    }
};
template <bool RESB, bool OUTF> struct EpiRes {
    static constexpr bool PERM = false, AFTER_DRAIN = false; static constexpr int HOOK_T = -1;
    const float* res_p; const float* res_s; const bf16* resb; float* out; bf16* outb; float* ss; float scale;
    __device__ __forceinline__ void operator()(const f32x4 (&acc)[2][2][4][2], const pg8::Unit& u, int wr, int wc, int fr, int fq) const {
        const int row0 = u.pm * 256 + wr * 64 + fr, col0 = u.pn * 256 + wc * 32 + 4 * fq;
#pragma unroll
        for (int ai = 0; ai < 2; ++ai)
#pragma unroll
            for (int m = 0; m < 4; ++m) { const int row = row0 + ai * 128 + m * 16;
                if (row < MV) {
                    const float* rp = (row < MPR) ? res_p + (size_t)row * DM : res_s + (size_t)(row - MPR) * DM;
                    float s = 0.f;
#pragma unroll
                    for (int bj = 0; bj < 2; ++bj)
#pragma unroll
                        for (int n = 0; n < 2; ++n) { const int col = col0 + bj * 128 + n * 16; f32x4 r;
                            if (RESB) { const u32x2 rw = *(const u32x2*)(resb + (size_t)row * DM + col); r = (f32x4){bf2f(rw.x & 0xffff), bf2f(rw.x >> 16), bf2f(rw.y & 0xffff), bf2f(rw.y >> 16)}; }
                            else r = *(const f32x4*)(rp + col);
                            const f32x4 v = r + acc[ai][bj][m][n] * scale;
                            if (OUTF) *(f32x4*)(out + (size_t)row * DM + col) = v;
                            else { u32x2 w; w.x = cvt_pk_bf16(v[0], v[1]); w.y = cvt_pk_bf16(v[2], v[3]); *(u32x2*)(outb + (size_t)row * DM + col) = w;
                                s += (v[0] * v[0] + v[1] * v[1]) + (v[2] * v[2] + v[3] * v[3]); } }
                    if (!OUTF) { s += __shfl_xor(s, 16); s += __shfl_xor(s, 32); if (fq == 0) atomicAdd(ss + row, s); }
                }
            }
    }
};
struct EpiQKV {
    static constexpr bool PERM = false, AFTER_DRAIN = false; static constexpr int HOOK_T = -1;
    const float* ss; unsigned char* wsb; bf16* G; float* dout; const float* GT;
    __device__ __forceinline__ void operator()(const f32x4 (&acc)[2][2][4][2], const pg8::Unit& u, int wr, int wc, int fr, int fq) const {
        const int row0 = u.pm * 256 + wr * 64 + fr;
        if (u.pn >= 12) {
            const int col0 = (u.pn - 12) * 256 + wc * 32 + 4 * fq;
#pragma unroll
            for (int ai = 0; ai < 2; ++ai)
#pragma unroll
                for (int m = 0; m < 4; ++m) { const int row = row0 + ai * 128 + m * 16; const float rs = __builtin_amdgcn_rsqf(ss[row] * (1.f / DM) + EPS);
#pragma unroll
                    for (int bj = 0; bj < 2; ++bj)
#pragma unroll
                        for (int n = 0; n < 2; ++n) { const f32x4 a = acc[ai][bj][m][n] * rs; u32x2 w; w.x = cvt_pk_bf16(sigmoidf_(a[0]), sigmoidf_(a[1])); w.y = cvt_pk_bf16(sigmoidf_(a[2]), sigmoidf_(a[3]));
                            *(u32x2*)(G + (size_t)row * 2048 + col0 + bj * 128 + n * 16) = w; } }
            return;
        }
        const int hd = 4 * u.pn + wc;
        const bool isA = hd < 12; const int hb = isA ? 0 : hd - 12, t = hb / 12, jj = hb - 12 * t, g = isA ? 0 : (jj >> 2);
        const int kind = isA ? ((hd >= 8) + (hd >= 10)) : t;
        const int hs = isA ? (hd & 1) : (jj & 3), H = isA ? 2 : 4;
        const int idx = isA ? (kind == 0 ? hd : hs) : ((kind == 0 ? 8 : 2) + jj);
        const int sh = 2 * g, dil = 1 << sh, win = 128 << sh;
        const size_t so_p = isA ? O_AP : (O_B1P + (g > 0 ? O_B2P - O_B1P : 0) + (g > 1 ? O_B3P - O_B2P : 0));
        const size_t so_s = isA ? O_AS : (O_B1S + (g > 0 ? O_B2S - O_B1S : 0) + (g > 1 ? O_B3S - O_B2S : 0));
        const int gi = (kind == 2) ? 4 : ((isA ? 0 : 2) + kind);
        const size_t boff = WS_QP + (kind > 0 ? WS_KP - WS_QP : 0) + (kind > 1 ? WS_VP - WS_KP : 0); const int nh = kind == 0 ? 20 : 14;
        f32x4 gv[2][2];
#pragma unroll
        for (int bj = 0; bj < 2; ++bj)
#pragma unroll
            for (int n = 0; n < 2; ++n) gv[bj][n] = *(const f32x4*)(GT + gi * 64 + 32 * bj + 16 * n + 4 * fq);
#pragma unroll
        for (int ai = 0; ai < 2; ++ai)
#pragma unroll
            for (int m = 0; m < 4; ++m) { const int row = row0 + ai * 128 + m * 16; const float rs = __builtin_amdgcn_rsqf(ss[row] * (1.f / DM) + EPS);
                f32x4 v[2][2]; float s = 0.f;
#pragma unroll
                for (int bj = 0; bj < 2; ++bj)
#pragma unroll
                    for (int n = 0; n < 2; ++n) { v[bj][n] = acc[ai][bj][m][n] * rs; s += (v[bj][n][0] * v[bj][n][0] + v[bj][n][1] * v[bj][n][1]) + (v[bj][n][2] * v[bj][n][2] + v[bj][n][3] * v[bj][n][3]); }
                s += __shfl_xor(s, 16); s += __shfl_xor(s, 32);
                const float inv = (kind < 2) ? __builtin_amdgcn_rsqf(s * (1.f / 64.f) + EPS) : 1.f;
#pragma unroll
                for (int bj = 0; bj < 2; ++bj)
#pragma unroll
                    for (int n = 0; n < 2; ++n) v[bj][n] = v[bj][n] * gv[bj][n] * inv;
                if (row < MPR) {
                    const int b = row >> 11, sq = row & 2047, p = ((sq & (dil - 1)) << (11 - sh)) + (sq >> sh);
                    bf16* dst = (bf16*)(wsb + boff) + ((size_t)(b * nh + idx) * 2048 + p) * 64;
#pragma unroll
                    for (int bj = 0; bj < 2; ++bj)
#pragma unroll
                        for (int n = 0; n < 2; ++n) { u32x2 w; w.x = cvt_pk_bf16(v[bj][n][0], v[bj][n][1]); w.y = cvt_pk_bf16(v[bj][n][2], v[bj][n][3]); *(u32x2*)(dst + 32 * bj + 16 * n + 4 * fq) = w; }
                    if (kind > 0 && sq >= 2048 - win) {
                        float* sd = dout + so_p + ((((size_t)b * win + (sq - (2048 - win))) * 2 + (kind - 1)) * H + hs) * 64;
#pragma unroll
                        for (int bj = 0; bj < 2; ++bj)
#pragma unroll
                            for (int n = 0; n < 2; ++n) __builtin_nontemporal_store(v[bj][n], (f32x4*)(sd + 32 * bj + 16 * n + 4 * fq));
                    }
                } else if (row < MV) {
                    const int nn = row - MPR;
                    if (kind == 0) { float* sd = (float*)(wsb + WS_QS) + ((size_t)nn * 20 + idx) * 64;
#pragma unroll
                        for (int bj = 0; bj < 2; ++bj)
#pragma unroll
                            for (int n = 0; n < 2; ++n) *(f32x4*)(sd + 32 * bj + 16 * n + 4 * fq) = v[bj][n];
                    } else { float* sd = dout + so_s + ((((size_t)nn * win + (win - 1)) * 2 + (kind - 1)) * H + hs) * 64;
#pragma unroll
                        for (int bj = 0; bj < 2; ++bj)
#pragma unroll
                            for (int n = 0; n < 2; ++n) *(f32x4*)(sd + 32 * bj + 16 * n + 4 * fq) = v[bj][n];
                    }
                }
            }
    }
};
struct EpiUp {
    static constexpr bool PERM = true, AFTER_DRAIN = false; static constexpr int HOOK_T = 8;
    const bf16* G; bf16* MIXB;
    __device__ __forceinline__ void hook(f32x4 (&acc)[2][2][4][2], const pg8::Unit& u, int wr, int wc, int fr_, int fq) const {
        int fr = fr_; asm volatile("" : "+v"(fr));
        const int row0 = u.pm * 256 + wr * 64 + fr, col0 = u.pn * 256 + wc * 32 + 8 * fq;
#pragma unroll
        for (int ai = 0; ai < 2; ++ai)
#pragma unroll
            for (int m = 0; m < 4; ++m) { const int row = row0 + ai * 128 + m * 16;
#pragma unroll
                for (int bj = 0; bj < 2; ++bj) { const int col = col0 + bj * 128;
                    const unsigned goff = (unsigned)(row * 2048 + col) * 2u;
                    const u32x4 ga = *(const u32x4*)((const char*)G + goff), gb = *(const u32x4*)((const char*)G + goff + 2048u);
#define RT(a, b) ((a) * __builtin_amdgcn_rcpf(fmaxf((b), 1e-20f)))
                    const f32x4 r0 = {RT(bf2f(ga.x & 0xffff), bf2f(gb.x & 0xffff)), RT(bf2f(ga.x >> 16), bf2f(gb.x >> 16)), RT(bf2f(ga.y & 0xffff), bf2f(gb.y & 0xffff)), RT(bf2f(ga.y >> 16), bf2f(gb.y >> 16))};
                    const f32x4 r1 = {RT(bf2f(ga.z & 0xffff), bf2f(gb.z & 0xffff)), RT(bf2f(ga.z >> 16), bf2f(gb.z >> 16)), RT(bf2f(ga.w & 0xffff), bf2f(gb.w & 0xffff)), RT(bf2f(ga.w >> 16), bf2f(gb.w >> 16))};
#undef RT
                    acc[ai][bj][m][0] = acc[ai][bj][m][0] * r0; acc[ai][bj][m][1] = acc[ai][bj][m][1] * r1;
                    asm volatile("" ::: "memory"); } }
    }
    __device__ __forceinline__ void operator()(const f32x4 (&acc)[2][2][4][2], const pg8::Unit& u, int wr, int wc, int fr, int fq) const {
        const int row0 = u.pm * 256 + wr * 64 + fr, col0 = u.pn * 256 + wc * 32 + 8 * fq;
#pragma unroll
        for (int ai = 0; ai < 2; ++ai)
#pragma unroll
            for (int m = 0; m < 4; ++m) { const int row = row0 + ai * 128 + m * 16;
#pragma unroll
                for (int bj = 0; bj < 2; ++bj) { const int col = col0 + bj * 128;
                    const u32x4 gb = *(const u32x4*)(G + (size_t)row * 2048 + 1024 + col);
                    const f32x4 g0 = {fmaxf(bf2f(gb.x & 0xffff), 1e-20f), fmaxf(bf2f(gb.x >> 16), 1e-20f), fmaxf(bf2f(gb.y & 0xffff), 1e-20f), fmaxf(bf2f(gb.y >> 16), 1e-20f)};
                    const f32x4 g1 = {fmaxf(bf2f(gb.z & 0xffff), 1e-20f), fmaxf(bf2f(gb.z >> 16), 1e-20f), fmaxf(bf2f(gb.w & 0xffff), 1e-20f), fmaxf(bf2f(gb.w >> 16), 1e-20f)};
                    const f32x4 v0 = acc[ai][bj][m][0] * g0, v1 = acc[ai][bj][m][1] * g1;
                    u32x4 w; w.x = cvt_pk_bf16(v0[0], v0[1]); w.y = cvt_pk_bf16(v0[2], v0[3]); w.z = cvt_pk_bf16(v1[0], v1[1]); w.w = cvt_pk_bf16(v1[2], v1[3]);
                    *(u32x4*)(MIXB + (size_t)row * DM + col) = w; } }
    }
};

__device__ __forceinline__ int crow_c(int r) { return (r & 3) + 8 * (r >> 2); }
__device__ __forceinline__ s16x4 vtr(const LAS unsigned char* p) { typedef short v4i16_t __attribute__((ext_vector_type(4))); return __builtin_bit_cast(s16x4, __builtin_amdgcn_ds_read_tr16_b64_v4i16((LAS v4i16_t*)p)); }

__device__ __forceinline__ void phase_attention(KParams P, LAS unsigned char* lds, const int wave_sg) {
    const int tid = TID_NOW(wave_sg), lane = tid & 63, wave = wave_sg;
    unsigned char* ws = P->ws;
    const bf16* QP = (const bf16*)(ws + WS_QP); const bf16* KP = (const bf16*)(ws + WS_KP); const bf16* VP = (const bf16*)(ws + WS_VP);
    const float* QS = (const float*)(ws + WS_QS);
    bf16* OA = (bf16*)(ws + WS_XAB); bf16* OB3 = (bf16*)(ws + WS_OB3); float* LSE3 = (float*)(ws + WS_LSE3);
    const float* sinks = P->in[16];
    {
        LAS float* pl = (LAS float*)(lds + ATT_PL) + wave * 192;
        for (int widx = blockIdx.x * 8 + wave; widx < NS * 20; widx += gridDim.x * 8) {
            const int n = widx / 20, hq = widx % 20;
            const float* cache; int H, L, dil, h; size_t so; int g = 0, slot = 0;
            if (hq < 8) { cache = P->in[2]; H = 2; L = 128; dil = 1; h = hq >> 2; so = O_AS; }
            else { const int jj = hq - 8; g = jj >> 2; slot = jj & 3; h = slot; H = 4; dil = 1 << (2 * g); L = 128 * dil; cache = (g > 1) ? P->in[5] : (g > 0 ? P->in[4] : P->in[3]); so = O_B1S + (g > 0 ? O_B2S - O_B1S : 0) + (g > 1 ? O_B3S - O_B2S : 0); }
            const float slope2 = exp2f(-0.4f * (float)(hq + 1)) * LOG2E * (float)dil;
            const float* newk = P->out + so + ((((size_t)n * L + (L - 1)) * 2 + 0) * H + h) * 64;
            const float* newv = newk + H * 64;
            const float* cb = cache + (size_t)n * L * 2 * H * 64;
            const f32x4* q4 = (const f32x4*)(QS + ((size_t)n * 20 + hq) * 64);
            float sv[3];
#pragma unroll
            for (int rd = 0; rd < 3; ++rd) {
                const int mm = lane + 64 * rd; const bool valid = mm <= 128; const int mc = valid ? mm : 0;
                const f32x4* k4 = (const f32x4*)((mc == 0) ? newk : cb + ((size_t)(L - dil * mc) * 2 * H + h) * 64);
                float dot = 0.f;
#pragma unroll
                for (int d = 0; d < 16; ++d) { const f32x4 a = q4[d], b = k4[d]; dot += (a[0] * b[0] + a[1] * b[1]) + (a[2] * b[2] + a[3] * b[3]); }
                sv[rd] = valid ? dot - slope2 * (float)mm : -1e30f;
            }
            float mx = wave_max(fmaxf(fmaxf(sv[0], sv[1]), sv[2]));
            float sink2 = 0.f;
            if (hq < 8) { sink2 = sinks[hq] * LOG2E; mx = fmaxf(mx, sink2); }
            float lsum = 0.f;
#pragma unroll
            for (int rd = 0; rd < 3; ++rd) { const float p = __builtin_amdgcn_exp2f(sv[rd] - mx); pl[lane + 64 * rd] = p; lsum += p; }
            lsum = wave_sum(lsum);
            if (hq < 8) lsum += __builtin_amdgcn_exp2f(sink2 - mx);
            asm volatile("s_waitcnt lgkmcnt(0)" ::: "memory");
            const int kg = lane >> 4, dq = lane & 15;
            f32x4 o4 = {0.f, 0.f, 0.f, 0.f};
#pragma unroll
            for (int i0 = 0; i0 < 33; i0 += 11) {
                f32x4 vv[11]; float pp[11];
#pragma unroll
                for (int i = 0; i < 11; ++i) { const int mm = 4 * (i0 + i) + kg; const int mc = mm <= 128 ? mm : 128;
                    const float* vp = (mc == 0) ? newv : cb + ((size_t)(L - dil * mc) * 2 * H + H + h) * 64;
                    vv[i] = *(const f32x4*)(vp + 4 * dq); pp[i] = pl[mm]; }
#pragma unroll
                for (int i = 0; i < 11; ++i) o4 = o4 + vv[i] * pp[i];
            }
#pragma unroll
            for (int c = 0; c < 4; ++c) { o4[c] += __shfl_xor(o4[c], 16); o4[c] += __shfl_xor(o4[c], 32); }
            const float il = __builtin_amdgcn_rcpf(lsum);
            const size_t row = MPR + n;
            u32x2 ow; ow.x = cvt_pk_bf16(o4[0] * il, o4[1] * il); ow.y = cvt_pk_bf16(o4[2] * il, o4[3] * il);
            if (hq < 8) { if (kg == 0) *(u32x2*)(OA + row * 768 + hq * 64 + 4 * dq) = ow; }
            else { if (kg == 0) *(u32x2*)(OB3 + ((size_t)g * MP + row) * 256 + slot * 64 + 4 * dq) = ow; if (lane == 0) LSE3[((size_t)g * MP + row) * 4 + slot] = (mx + __builtin_amdgcn_logf(lsum)) * LN2; }
            asm volatile("s_waitcnt lgkmcnt(0)" ::: "memory");
        }
    }
    const int half = wave >> 2, w = wave & 3, r32 = lane & 31, hi = lane >> 5, htid = tid & 255;
    LAS unsigned char* Kl = lds + half * ATT_HALF; LAS unsigned char* Vl = Kl + 256 * ATT_KROW;
    u32x4 kreg[8], vreg[8]; bf16x8 qn[4];
#define ATT_DECODE(pair_) const int it = 2 * (pair_) + half, b = it / 320, rem = it - 320 * b, hq = rem >> 4, j = rem & 15; \
        const int jj = hq - 8, g = hq < 8 ? 0 : (jj >> 2), slot = jj & 3, kidx = hq < 8 ? (hq >> 2) : 2 + jj, dil = 1 << (2 * g)
#define ATT_LOAD(pair_) do { ATT_DECODE(pair_); const int krow0 = 128 * j - 128; \
        const bf16* Kg = KP + ((size_t)(b * 14 + kidx) * 2048) * 64; const bf16* Vg = VP + ((size_t)(b * 14 + kidx) * 2048) * 64; \
        const bf16* Qg = QP + ((size_t)(b * 20 + hq) * 2048 + 128 * j + 32 * w + r32) * 64 + hi * 8; \
        _Pragma("unroll") for (int d0 = 0; d0 < 4; ++d0) qn[d0] = *(const bf16x8*)(Qg + d0 * 16); \
        _Pragma("unroll") for (int c = 0; c < 8; ++c) { const int ch = htid + 256 * c; int grow = krow0 + (ch >> 3); grow = grow < 0 ? grow + 128 : grow; const size_t off = (size_t)grow * 64 + (ch & 7) * 8; \
            kreg[c] = *(const u32x4*)(Kg + off); vreg[c] = *(const u32x4*)(Vg + off); } } while (0)
    if ((int)blockIdx.x < 2560) ATT_LOAD((int)blockIdx.x);
    for (int pair = blockIdx.x; pair < 2560; pair += gridDim.x) {
        ATT_DECODE(pair);
        const int nblk = 16 >> (2 * g), blk = j & (nblk - 1), rres = j >> (4 - 2 * g); const bool hasprev = blk != 0;
        const float sd = exp2f(-0.4f * (float)(hq + 1)) * LOG2E * (float)dil;
        __syncthreads();
#pragma unroll
        for (int c = 0; c < 8; ++c) { const int ch = htid + 256 * c, row = ch >> 3, cc = ch & 7; *(LAS u32x4*)(Kl + row * ATT_KROW + cc * 16) = kreg[c]; *(LAS u32x4*)(Vl + row * ATT_KROW + cc * 16) = vreg[c]; }
        bf16x8 qf[4];
#pragma unroll
        for (int d0 = 0; d0 < 4; ++d0) qf[d0] = qn[d0];
        __syncthreads();
        if (pair + (int)gridDim.x < 2560) ATT_LOAD(pair + (int)gridDim.x);
        float sink2 = 0.f, mx = -1e30f, lsum = 0.f;
        if (hq < 8) { sink2 = sinks[hq] * LOG2E; mx = sink2; lsum = hi == 0 ? 1.f : 0.f; }
        f32x16 o[2];
        o[0] = (f32x16){0.f, 0.f, 0.f, 0.f, 0.f, 0.f, 0.f, 0.f, 0.f, 0.f, 0.f, 0.f, 0.f, 0.f, 0.f, 0.f}; o[1] = o[0];
        const LAS unsigned char* vb = Vl + (32 * w + 4 * hi + ((lane & 15) >> 2)) * ATT_KROW + (16 * ((lane >> 4) & 1) + 4 * (lane & 3)) * 2;
#pragma unroll
        for (int kbi = 0; kbi < 5; ++kbi) { const int kb = 4 - kbi;
            f32x16 S = (f32x16){0.f, 0.f, 0.f, 0.f, 0.f, 0.f, 0.f, 0.f, 0.f, 0.f, 0.f, 0.f, 0.f, 0.f, 0.f, 0.f};
            const LAS unsigned char* kp = Kl + (32 * w + 32 * kb + r32) * ATT_KROW + hi * 16;
#pragma unroll
            for (int d0 = 0; d0 < 4; ++d0) { const bf16x8 kf = *(const LAS bf16x8*)(kp + d0 * 32); S = __builtin_amdgcn_mfma_f32_32x32x16_bf16(kf, qf[d0], S, 0, 0, 0); }
            float tmax = -1e30f;
#pragma unroll
            for (int r = 0; r < 16; ++r) { const int c = crow_c(r) + 4 * hi; const int dist = r32 + 128 - 32 * kb - c;
                float v = S[r] - sd * (float)dist;
                if (kb == 0) v = dist <= 128 ? v : -1e30f;
                if (kb == 4) v = dist >= 0 ? v : -1e30f;
                if (kb < 4) { const int ki = 32 * w + 32 * kb + c; v = (hasprev || ki >= 128) ? v : -1e30f; }
                S[r] = v; tmax = fmaxf(tmax, v); }
            tmax = fmaxf(tmax, __shfl_xor(tmax, 32));
            const float mnew = fmaxf(mx, tmax);
            if (kbi > 0 && __builtin_amdgcn_ballot_w64(mnew > mx) != 0ull) { const float al = __builtin_amdgcn_exp2f(mx - mnew); lsum *= al;
#pragma unroll
                for (int r = 0; r < 16; ++r) { o[0][r] *= al; o[1][r] *= al; } }
            else if (kbi == 0) lsum *= __builtin_amdgcn_exp2f(mx - mnew);
            mx = mnew;
#pragma unroll
            for (int r = 0; r < 16; ++r) { const float p = __builtin_amdgcn_exp2f(S[r] - mx); S[r] = p; lsum += p; }
#pragma unroll
            for (int kk = 0; kk < 2; ++kk) {
                u32x4 pw; pw.x = cvt_pk_bf16(S[8 * kk + 0], S[8 * kk + 1]); pw.y = cvt_pk_bf16(S[8 * kk + 2], S[8 * kk + 3]); pw.z = cvt_pk_bf16(S[8 * kk + 4], S[8 * kk + 5]); pw.w = cvt_pk_bf16(S[8 * kk + 6], S[8 * kk + 7]);
                const bf16x8 pf = __builtin_bit_cast(bf16x8, pw);
#pragma unroll
                for (int dh = 0; dh < 2; ++dh) {
                    const LAS unsigned char* vp = vb + (32 * kb + 16 * kk) * ATT_KROW + dh * 64;
                    const s16x4 lo = vtr(vp), hh = vtr(vp + 8 * ATT_KROW);
                    const bf16x8 vf = {lo[0], lo[1], lo[2], lo[3], hh[0], hh[1], hh[2], hh[3]};
                    o[dh] = __builtin_amdgcn_mfma_f32_32x32x16_bf16(vf, pf, o[dh], 0, 0, 0);
                }
            }
        }
        lsum += __shfl_xor(lsum, 32);
        const float inv = __builtin_amdgcn_rcpf(lsum);
        const int sq = (blk * 128 + 32 * w + r32) * dil + rres; const size_t row = (size_t)b * 2048 + sq;
        bf16* dst = (hq < 8) ? OA + row * 768 + hq * 64 : OB3 + ((size_t)g * MP + row) * 256 + slot * 64;
#pragma unroll
        for (int dh = 0; dh < 2; ++dh)
#pragma unroll
            for (int c = 0; c < 4; ++c) { u32x2 wv; wv.x = cvt_pk_bf16(o[dh][4 * c] * inv, o[dh][4 * c + 1] * inv); wv.y = cvt_pk_bf16(o[dh][4 * c + 2] * inv, o[dh][4 * c + 3] * inv);
                *(u32x2*)(dst + 32 * dh + 8 * c + 4 * hi) = wv; }
        if (hq >= 8 && hi == 0) LSE3[((size_t)g * MP + row) * 4 + slot] = (mx + __builtin_amdgcn_logf(lsum)) * LN2;
    }
#undef ATT_LOAD
#undef ATT_DECODE
    __syncthreads();
}

__device__ __forceinline__ void phase_merge(KParams P, const int wave_sg) {
    unsigned char* ws = P->ws;
    const bf16* OB3 = (const bf16*)(ws + WS_OB3); const float* LSE3 = (const float*)(ws + WS_LSE3); bf16* OBM = (bf16*)(ws + WS_XAB) + 512;
    const long gtid = (long)blockIdx.x * 512 + TID_NOW(wave_sg), gthreads = (long)gridDim.x * 512;
    for (long i = gtid; i < (long)MV * 32; i += gthreads) {
        const long row = i >> 5; const int ch = (int)(i & 31), slot = ch >> 3;
        float l[3], mx = -1e30f;
#pragma unroll
        for (int g = 0; g < 3; ++g) { l[g] = LSE3[((size_t)g * MP + row) * 4 + slot]; mx = fmaxf(mx, l[g]); }
        float wsum = 0.f;
#pragma unroll
        for (int g = 0; g < 3; ++g) { l[g] = __builtin_amdgcn_exp2f((l[g] - mx) * LOG2E); wsum += l[g]; }
        const float inv = __builtin_amdgcn_rcpf(wsum);
        float a[8] = {0.f, 0.f, 0.f, 0.f, 0.f, 0.f, 0.f, 0.f};
#pragma unroll
        for (int g = 0; g < 3; ++g) { const u32x4 v = *(const u32x4*)(OB3 + ((size_t)g * MP + row) * 256 + ch * 8); const float wg = l[g] * inv;
            a[0] += wg * bf2f(v.x & 0xffff); a[1] += wg * bf2f(v.x >> 16); a[2] += wg * bf2f(v.y & 0xffff); a[3] += wg * bf2f(v.y >> 16);
            a[4] += wg * bf2f(v.z & 0xffff); a[5] += wg * bf2f(v.z >> 16); a[6] += wg * bf2f(v.w & 0xffff); a[7] += wg * bf2f(v.w >> 16); }
        u32x4 o; o.x = cvt_pk_bf16(a[0], a[1]); o.y = cvt_pk_bf16(a[2], a[3]); o.z = cvt_pk_bf16(a[4], a[5]); o.w = cvt_pk_bf16(a[6], a[7]);
        *(u32x4*)(OBM + row * 768 + ch * 8) = o;
    }
}

#define GEMM_PHASE(EPI, A_, B_, N_, K_, E_) do { pg8::Gemm g_{(const bf16*)(A_), (const bf16*)(B_), MP, (N_), (K_)}; pg8::SplitOrder S_; S_.init((N_), (K_), (int)gridDim.x, (int)blockIdx.x, 1, nullptr, nullptr); \
    pg8::gemm_phase<std::remove_reference_t<decltype(E_)>, pg8::SplitOrder, true, true>(lds, g_, S_, E_, wave_sg); } while (0)
#define GEMM_PHASE_BG(EPI, A_, B_, N_, K_, E_, BG_, SPLIT_, ACCI_) do { pg8::Gemm g_{(const bf16*)(A_), (const bf16*)(B_), MP, (N_), (K_)}; pg8::SplitOrder S_; \
    S_.init((N_), (K_), (int)gridDim.x, (int)blockIdx.x, (SPLIT_), (float*)(ws + WS_ACC) + (size_t)(ACCI_) * ACC_FLOATS, (unsigned*)(ws + WS_ACC + 3 * ACC_FLOATS * 4) + 64 * (ACCI_)); \
    pg8::gemm_phase<std::remove_reference_t<decltype(E_)>, pg8::SplitOrder, true, true, std::remove_reference_t<decltype(BG_)>>(lds, g_, S_, E_, wave_sg, BG_); } while (0)
typedef pg8::BgCopy<2047u * 128u, 2048u * 128u, 128u> BgB3;
typedef pg8::BgCopy<511u * 128u, 512u * 128u, 128u> BgB2;
constexpr unsigned BG_IT = 256u * 512u;
constexpr unsigned B3_TOT = 128u * 2047u * 128u, B2_TOT = 128u * 511u * 128u;
constexpr unsigned B3_C1 = 88u * BG_IT, B3_C2 = B3_C1 + 44u * BG_IT, B3_C3 = B3_C2 + 80u * BG_IT;
constexpr unsigned B2_C1 = 44u * BG_IT;
static_assert(B3_TOT - B3_C3 <= 88u * BG_IT && B2_C1 < B2_TOT, "background copy capacity");

#define LOADP(P_) KParams P_ = kp0; asm volatile("" : "+s"(P_)); unsigned char* const ws = P_->ws; (void)ws
__global__ void __launch_bounds__(512, 2) mega_fwd(Params Parg) {
    extern __shared__ __attribute__((aligned(16))) unsigned char lds_raw[];
    LAS unsigned char* lds = (LAS unsigned char*)lds_raw;
    cg::grid_group grid = cg::this_grid();
    const KParams kp0 = (KParams)__builtin_amdgcn_kernarg_segment_ptr();
    const int wave_sg = __builtin_amdgcn_readfirstlane(threadIdx.x >> 6);
    volatile LAS unsigned* xb_st = (volatile LAS unsigned*)(lds + LDS_BYTES - 16);
    if (TID_NOW(wave_sg) < 4) xb_st[TID_NOW(wave_sg)] = 0u;
    __syncthreads();
    const XcdBarrier xbar = xcd_barrier_post((unsigned*)(kp0->ws + WS_BAR), xb_st, wave_sg);
#define GRID_BAR() xcd_barrier(xbar, wave_sg)
    { LOADP(P); phase_prologue(P, lds, wave_sg); }
    grid.sync();
    const int bgr = (gridDim.x == 256) ? 1 : 0;
    { LOADP(P); { EpiSwiGLU E{(bf16*)(ws + WS_H), (const float*)(ws + WS_SS1)}; BgB3 bg{(const f32x4*)P->in[5], (f32x4*)(P->out + O_B3S), (f32x4*)(ws + WS_DUMP), 0u, B3_C1, 11 * bgr};
        GEMM_PHASE_BG(EpiSwiGLU, ws + WS_XB, ws + WS_W1GU, 2 * DFF, DM, E, bg, 1, 0); }
      if (bgr) { idle_copy(P, 129 * 22, 0u, CP_S1, wave_sg); } }
    GRID_BAR();
    { LOADP(P); { EpiRes<false, false> E{P->in[0], P->in[1], nullptr, nullptr, (bf16*)(ws + WS_X1B), (float*)(ws + WS_SS2), 0.5f}; BgB3 bg{(const f32x4*)P->in[5], (f32x4*)(P->out + O_B3S), (f32x4*)(ws + WS_DUMP), B3_C1, B3_C2, 2 * bgr};
        GEMM_PHASE_BG(0, ws + WS_H, ws + WS_W1D, DM, DFF, E, bg, 11, 0); } }
    GRID_BAR();
    { LOADP(P); { EpiQKV E{(const float*)(ws + WS_SS2), ws, (bf16*)(ws + WS_G), P->out, (const float*)(ws + WS_GT)}; BgB3 bg{(const f32x4*)P->in[5], (f32x4*)(P->out + O_B3S), (f32x4*)(ws + WS_DUMP), B3_C2, B3_C3, 10 * bgr};
        GEMM_PHASE_BG(EpiQKV, ws + WS_X1B, ws + WS_WIN, INW, DM, E, bg, 1, 0); }
      if (bgr) { idle_copy(P, 129 * 20, CP_S1 + B2_C1, CP_S2, wave_sg); } }
    GRID_BAR();
    { LOADP(P); phase_attention(P, lds, wave_sg); }
    GRID_BAR();
    { LOADP(P); phase_merge(P, wave_sg); }
    GRID_BAR();
    { LOADP(P); EpiUp E{(const bf16*)(ws + WS_G), (bf16*)(ws + WS_MIXB)}; GEMM_PHASE(EpiUp, ws + WS_XAB, ws + WS_WUA, DM, 768, E); }
    GRID_BAR();
    { LOADP(P); { EpiRes<true, false> E{nullptr, nullptr, (const bf16*)(ws + WS_X1B), nullptr, (bf16*)(ws + WS_X2B), (float*)(ws + WS_SS3), 1.0f}; pg8::BgNone bg; GEMM_PHASE_BG(0, ws + WS_MIXB, ws + WS_WO, DM, DM, E, bg, 4, 2); } }
    GRID_BAR();
    { LOADP(P); { EpiSwiGLU E{(bf16*)(ws + WS_H), (const float*)(ws + WS_SS3)}; BgB3 bg{(const f32x4*)P->in[5], (f32x4*)(P->out + O_B3S), (f32x4*)(ws + WS_DUMP), B3_C3, B3_TOT, 11 * bgr};
        GEMM_PHASE_BG(EpiSwiGLU, ws + WS_X2B, ws + WS_W2GU, 2 * DFF, DM, E, bg, 1, 0); } }
    GRID_BAR();
    { LOADP(P); { EpiRes<true, true> E{nullptr, nullptr, (const bf16*)(ws + WS_X2B), P->out, nullptr, nullptr, 0.5f}; BgB2 bg{(const f32x4*)P->in[4], (f32x4*)(P->out + O_B2S), (f32x4*)(ws + WS_DUMP), 0u, B2_C1, 2 * bgr};
        GEMM_PHASE_BG(0, ws + WS_H, ws + WS_W2D, DM, DFF, E, bg, 11, 1); } }
}

extern "C" void kernel_launch(void* const* d_in, const int* in_sizes, int n_in, void* d_out, int out_size, void* d_ws, size_t ws_size, hipStream_t stream) {
    static int grid = 0;
    if (grid == 0) {
        if (n_in != 24 || ws_size < WS_END) { fprintf(stderr, "kernel_launch: unexpected n_in %d / ws_size %zu\n", n_in, ws_size); grid = -1; return; }
        int dev = 0, cus = 0, per_cu = 0;
        hipGetDevice(&dev); hipDeviceGetAttribute(&cus, hipDeviceAttributeMultiprocessorCount, dev);
        if (hipFuncSetAttribute((const void*)mega_fwd, hipFuncAttributeMaxDynamicSharedMemorySize, LDS_BYTES) != hipSuccess) { fprintf(stderr, "kernel_launch: hipFuncSetAttribute failed\n"); grid = -1; return; }
        if (hipOccupancyMaxActiveBlocksPerMultiprocessor(&per_cu, (const void*)mega_fwd, 512, LDS_BYTES) != hipSuccess || per_cu < 1) { fprintf(stderr, "kernel_launch: occupancy query says %d\n", per_cu); per_cu = 1; }
        (void)hipGetLastError();
        grid = cus * per_cu;
        fprintf(stderr, "kernel_launch: grid %d (cus %d x %d)\n", grid, cus, per_cu);
    }
    if (grid < 0) return;
    if (hipMemsetAsync((char*)d_ws + WS_BAR, 0, XCD_BAR_WORDS * 4, stream) != hipSuccess) { fprintf(stderr, "kernel_launch: hipMemsetAsync of the barrier words failed\n"); return; }
    Params p{};
    for (int i = 0; i < 24; ++i) p.in[i] = (const float*)d_in[i];
    p.out = (float*)d_out; p.ws = (unsigned char*)d_ws;
    void* args[] = {&p};
    hipError_t e = hipLaunchCooperativeKernel((const void*)mega_fwd, dim3(grid), dim3(512), args, LDS_BYTES, stream);
    if (e != hipSuccess) fprintf(stderr, "cooperative launch failed: %s (grid %d)\n", hipGetErrorString(e), grid);
}
```
